# Optimizing an MI355X kernel written in HIP

```python
import math
import jax, jax.numpy as jnp
from jax import lax
import numpy as np

D_MODEL = 1024
BATCH = 8
SEQ = 4096
DEPTH = 1

HEAD_DIM = 64
BLK = 128
RMS_EPS = 1e-6
NSA_HEADS = 8
NSA_KV_GROUPS = 2
NSA_CMP_LEN = 32
NSA_CMP_STRIDE = 16
NSA_CMP_HIDDEN = 256
NSA_SLC_LEN = 64
NSA_N_SEL = 16
NSA_WINDOW = 512
DIL_CONFIGS = ((128, 1), (512, 4), (2048, 16))
DIL_HEADS_PER_GROUP = 4
DIL_HEADS = DIL_HEADS_PER_GROUP * len(DIL_CONFIGS)
D_FF = ((8 * D_MODEL // 3 + 127) // 128) * 128
Q_NSA = NSA_HEADS * HEAD_DIM
KV_NSA = NSA_KV_GROUPS * HEAD_DIM
GATE_NSA = NSA_HEADS * 3
QKV_DIL = DIL_HEADS * HEAD_DIM
IN_DIM = Q_NSA + 6 * KV_NSA + GATE_NSA + 3 * QKV_DIL + 2 * D_MODEL
DIL_OUT = DIL_HEADS_PER_GROUP * HEAD_DIM

kernel_name = "hybrid_nsa_dilated_macaron_block"


def rms_norm(x, g):
    xf = x.astype(jnp.float32)
    y = xf * lax.rsqrt(jnp.mean(xf * xf, axis=-1, keepdims=True) + RMS_EPS)
    return (y * g.astype(jnp.float32)).astype(x.dtype)


def swiglu(x, w_gate, w_up, w_down):
    return (jax.nn.silu(x @ w_gate) * (x @ w_up)) @ w_down


def alibi_slopes(n):
    return jnp.asarray(2.0 ** (-8.0 * np.arange(1, n + 1) / n), dtype=jnp.float32)


def masked_softmax(s, mask):
    s = jnp.where(mask, s, -jnp.inf)
    m = jnp.max(s, axis=-1, keepdims=True)
    m = jnp.where(jnp.isfinite(m), m, 0.0)
    p = jnp.exp(s - m)
    den = jnp.maximum(jnp.sum(p, axis=-1, keepdims=True), 1e-30)
    return p / den, (m + jnp.log(den))[..., 0]


def banded_attention(q, k, v, n_prev, max_back, step, slopes):
    N, L, H, hd = q.shape
    G = k.shape[2]
    rep = H // G
    nb = L // BLK
    W = (n_prev + 1) * BLK
    qb = q.reshape(N, nb, BLK, G, rep, hd)

    def windows(t):
        tp = jnp.pad(t, ((0, 0), (n_prev * BLK, 0), (0, 0), (0, 0))).reshape(N, nb + n_prev, BLK, G, hd)
        return jnp.concatenate([tp[:, j:j + nb] for j in range(n_prev + 1)], axis=2)

    kw, vw = windows(k), windows(v)
    s = jnp.einsum('nbqgrd,nbkgd->nbgrqk', qb, kw, preferred_element_type=jnp.float32) * hd ** -0.5
    diff = (jnp.arange(BLK)[:, None] + n_prev * BLK) - jnp.arange(W)[None, :]
    key_abs = jnp.arange(nb)[:, None] * BLK - n_prev * BLK + jnp.arange(W)[None, :]
    s = s - slopes.reshape(G, rep)[:, :, None, None] * (diff * step).astype(jnp.float32)
    mask = ((diff >= 0) & (diff <= max_back))[None, None, None, None] & (key_abs >= 0)[None, :, None, None, None, :]
    p, lse = masked_softmax(s, mask)
    o = jnp.einsum('nbgrqk,nbkgd->nbqgrd', p.astype(v.dtype), vw).reshape(N, L, H, hd)
    lse = lse.transpose(0, 1, 4, 2, 3).reshape(N, L, H)
    return o, lse


def nsa_attention(q, k_cmp, v_cmp, k_slc, v_slc, k_win, v_win, gates,
                  pe_k, w_ck1, w_ck2, pe_v, w_cv1, w_cv2):
    B, S, H, hd = q.shape
    G = NSA_KV_GROUPS
    rep = H // G
    scale = hd ** -0.5
    slopes = alibi_slopes(H)
    sl_gr = slopes.reshape(G, rep)
    pos = jnp.arange(S)
    qg = q.reshape(B, S, G, rep, hd)

    n_cmp = (S - NSA_CMP_LEN) // NSA_CMP_STRIDE + 1
    blk_idx = jnp.arange(n_cmp)[:, None] * NSA_CMP_STRIDE + jnp.arange(NSA_CMP_LEN)[None, :]

    def compress(t, pe, w1, w2):
        tb = t[:, blk_idx] + pe[None, None, :, None, :]
        tb = tb.transpose(0, 1, 3, 2, 4).reshape(B, n_cmp, G, NSA_CMP_LEN * hd)
        return jax.nn.gelu(tb @ w1) @ w2

    kc = compress(k_cmp, pe_k, w_ck1, w_ck2)
    vc = compress(v_cmp, pe_v, w_cv1, w_cv2)
    cmp_end = jnp.arange(n_cmp) * NSA_CMP_STRIDE + NSA_CMP_LEN - 1
    dist_c = pos[:, None] - cmp_end[None, :]
    s_c = jnp.einsum('bsgrd,bcgd->bgrsc', qg, kc, preferred_element_type=jnp.float32) * scale
    s_c = s_c - sl_gr[:, :, None, None] * dist_c.astype(jnp.float32)
    p_cmp, _ = masked_softmax(s_c, dist_c >= 0)
    o_cmp = jnp.einsum('bgrsc,bcgd->bsgrd', p_cmp.astype(vc.dtype), vc).reshape(B, S, H, hd)

    n_slc = S // NSA_SLC_LEN
    c_start = jnp.arange(n_cmp) * NSA_CMP_STRIDE
    s_start = jnp.arange(n_slc) * NSA_SLC_LEN
    overlap = jnp.clip(jnp.minimum(c_start[:, None] + NSA_CMP_LEN, s_start[None, :] + NSA_SLC_LEN)
                       - jnp.maximum(c_start[:, None], s_start[None, :]), 0, None).astype(jnp.float32) / NSA_CMP_LEN
    imp = jnp.einsum('bgrsc,cj->bsgj', p_cmp, overlap)
    jb = jnp.arange(n_slc)[None, :]
    own = (pos // NSA_SLC_LEN)[:, None]
    forced = (jb == 0) | (jb == own) | (jb == own - 1)
    valid = jb * NSA_SLC_LEN <= pos[:, None]
    imp = jnp.where(forced[None, :, None, :], jnp.inf, jnp.where(valid[None, :, None, :], imp, -jnp.inf))
    n_sel = min(NSA_N_SEL, n_slc)
    _, sel = lax.top_k(imp, n_sel)

    kb = k_slc.reshape(B, n_slc, NSA_SLC_LEN, G, hd).transpose(0, 3, 1, 2, 4)
    vb = v_slc.reshape(B, n_slc, NSA_SLC_LEN, G, hd).transpose(0, 3, 1, 2, 4)
    nqb = S // BLK
    bi = jnp.arange(B)[:, None, None, None]
    gi = jnp.arange(G)[None, :, None, None]
    n_keys = n_sel * NSA_SLC_LEN

    def slc_block(args):
        qblk, selblk, qpos = args
        idx = selblk.transpose(0, 2, 1, 3)
        kg = kb[bi, gi, idx].reshape(B, G, BLK, n_keys, hd)
        vg = vb[bi, gi, idx].reshape(B, G, BLK, n_keys, hd)
        kpos = (idx[..., None] * NSA_SLC_LEN + jnp.arange(NSA_SLC_LEN)).reshape(B, G, BLK, n_keys)
        dist = qpos[None, None, :, None] - kpos
        s = jnp.einsum('bqgrd,bgqkd->bgrqk', qblk, kg, preferred_element_type=jnp.float32) * scale
        s = s - sl_gr[None, :, :, None, None] * dist[:, :, None].astype(jnp.float32)
        p, _ = masked_softmax(s, (dist >= 0)[:, :, None])
        return jnp.einsum('bgrqk,bgqkd->bqgrd', p.astype(vg.dtype), vg)

    xs = (qg.reshape(B, nqb, BLK, G, rep, hd).swapaxes(0, 1),
          sel.reshape(B, nqb, BLK, G, n_sel).swapaxes(0, 1),
          pos.reshape(nqb, BLK))
    o_slc = lax.map(slc_block, xs).swapaxes(0, 1).reshape(B, S, H, hd)

    o_win, _ = banded_attention(q, k_win, v_win, NSA_WINDOW // BLK, NSA_WINDOW - 1, 1, slopes)

    g = jax.nn.sigmoid(gates)
    return g[..., 0:1] * o_cmp + g[..., 1:2] * o_slc + g[..., 2:3] * o_win


def dilated_attention(q, k, v):
    B, S, _, hd = q.shape
    hpg = DIL_HEADS_PER_GROUP
    slopes = alibi_slopes(DIL_HEADS).reshape(len(DIL_CONFIGS), hpg)
    outs, lses = [], []
    for gidx, (window, dil) in enumerate(DIL_CONFIGS):
        Lp = -(-S // (dil * BLK)) * dil * BLK
        Ls = Lp // dil

        def strided(t):
            t = jnp.pad(t[:, :, gidx * hpg:(gidx + 1) * hpg], ((0, 0), (0, Lp - S), (0, 0), (0, 0)))
            return t.reshape(B, Ls, dil, hpg, hd).transpose(0, 2, 1, 3, 4).reshape(B * dil, Ls, hpg, hd)

        o, lse = banded_attention(strided(q), strided(k), strided(v), 1, window // dil, dil, slopes[gidx])
        outs.append(o.reshape(B, dil, Ls, hpg, hd).transpose(0, 2, 1, 3, 4).reshape(B, Lp, hpg, hd)[:, :S])
        lses.append(lse.reshape(B, dil, Ls, hpg).transpose(0, 2, 1, 3).reshape(B, Lp, hpg)[:, :S])
    w = jax.nn.softmax(jnp.stack(lses), axis=0)
    o = jnp.sum(w[..., None] * jnp.stack(outs).astype(jnp.float32), axis=0)
    return o.astype(q.dtype)


def token_mixer(h, w_in, pe_k, w_ck1, w_ck2, pe_v, w_cv1, w_cv2, w_nsa_o, w_dil_o, w_mix_out):
    B, S, _ = h.shape
    proj = h @ w_in
    sizes = [Q_NSA, 6 * KV_NSA, GATE_NSA, 3 * QKV_DIL, 2 * D_MODEL]
    q_n, kv_n, g_n, qkv_d, merge = jnp.split(proj, np.cumsum(sizes)[:-1].tolist(), axis=-1)
    q_n = q_n.reshape(B, S, NSA_HEADS, HEAD_DIM)
    kv_n = kv_n.reshape(B, S, 6, NSA_KV_GROUPS, HEAD_DIM)
    g_n = g_n.reshape(B, S, NSA_HEADS, 3)
    o_nsa = nsa_attention(q_n, kv_n[:, :, 0], kv_n[:, :, 1], kv_n[:, :, 2], kv_n[:, :, 3],
                          kv_n[:, :, 4], kv_n[:, :, 5], g_n, pe_k, w_ck1, w_ck2, pe_v, w_cv1, w_cv2)
    qkv_d = qkv_d.reshape(B, S, 3, DIL_HEADS, HEAD_DIM)
    o_dil = dilated_attention(qkv_d[:, :, 0], qkv_d[:, :, 1], qkv_d[:, :, 2])
    y_nsa = o_nsa.reshape(B, S, Q_NSA) @ w_nsa_o
    y_dil = o_dil.reshape(B, S, DIL_OUT) @ w_dil_o
    g_a, g_b = jnp.split(merge, 2, axis=-1)
    y = jax.nn.sigmoid(g_a) * y_nsa + jax.nn.sigmoid(g_b) * y_dil
    return y @ w_mix_out


def setup_inputs(seed: int = 0) -> dict:
    key = jax.random.key(seed)
    ks = iter(jax.random.split(key, 32))

    def w(shape, fan_in):
        return jax.random.normal(next(ks), (DEPTH,) + shape, jnp.float32) * fan_in ** -0.5

    def gain():
        return 1.0 + 0.01 * jax.random.normal(next(ks), (DEPTH, D_MODEL), jnp.float32)

    inp = {}
    inp["x"] = jax.random.normal(next(ks), (BATCH, SEQ, D_MODEL), jnp.float32)
    inp["ffn1_pre"] = gain()
    inp["ffn1_post"] = gain()
    inp["ffn1_w_gate"] = w((D_MODEL, D_FF), D_MODEL)
    inp["ffn1_w_up"] = w((D_MODEL, D_FF), D_MODEL)
    inp["ffn1_w_down"] = w((D_FF, D_MODEL), D_FF)
    inp["mix_pre"] = gain()
    inp["mix_post"] = gain()
    inp["w_in"] = w((D_MODEL, IN_DIM), D_MODEL)
    inp["nsa_pe_k"] = 0.1 * jax.random.normal(next(ks), (DEPTH, NSA_CMP_LEN, HEAD_DIM), jnp.float32)
    inp["nsa_w_ck1"] = w((NSA_CMP_LEN * HEAD_DIM, NSA_CMP_HIDDEN), NSA_CMP_LEN * HEAD_DIM)
    inp["nsa_w_ck2"] = w((NSA_CMP_HIDDEN, HEAD_DIM), NSA_CMP_HIDDEN)
    inp["nsa_pe_v"] = 0.1 * jax.random.normal(next(ks), (DEPTH, NSA_CMP_LEN, HEAD_DIM), jnp.float32)
    inp["nsa_w_cv1"] = w((NSA_CMP_LEN * HEAD_DIM, NSA_CMP_HIDDEN), NSA_CMP_LEN * HEAD_DIM)
    inp["nsa_w_cv2"] = w((NSA_CMP_HIDDEN, HEAD_DIM), NSA_CMP_HIDDEN)
    inp["w_nsa_o"] = w((Q_NSA, D_MODEL), Q_NSA)
    inp["w_dil_o"] = w((DIL_OUT, D_MODEL), DIL_OUT)
    inp["w_mix_out"] = w((D_MODEL, D_MODEL), D_MODEL)
    inp["ffn2_pre"] = gain()
    inp["ffn2_post"] = gain()
    inp["ffn2_w_gate"] = w((D_MODEL, D_FF), D_MODEL)
    inp["ffn2_w_up"] = w((D_MODEL, D_FF), D_MODEL)
    inp["ffn2_w_down"] = w((D_FF, D_MODEL), D_FF)
    return inp


def reference(x, ffn1_pre, ffn1_post, ffn1_w_gate, ffn1_w_up, ffn1_w_down,
              mix_pre, mix_post, w_in, nsa_pe_k, nsa_w_ck1, nsa_w_ck2,
              nsa_pe_v, nsa_w_cv1, nsa_w_cv2, w_nsa_o, w_dil_o, w_mix_out,
              ffn2_pre, ffn2_post, ffn2_w_gate, ffn2_w_up, ffn2_w_down):
    for l in range(DEPTH):
        h = rms_norm(x, ffn1_pre[l])
        x = x + 0.5 * rms_norm(swiglu(h, ffn1_w_gate[l], ffn1_w_up[l], ffn1_w_down[l]), ffn1_post[l])
        h = rms_norm(x, mix_pre[l])
        y = token_mixer(h, w_in[l], nsa_pe_k[l], nsa_w_ck1[l], nsa_w_ck2[l], nsa_pe_v[l],
                        nsa_w_cv1[l], nsa_w_cv2[l], w_nsa_o[l], w_dil_o[l], w_mix_out[l])
        x = x + rms_norm(y, mix_post[l])
        h = rms_norm(x, ffn2_pre[l])
        x = x + 0.5 * rms_norm(swiglu(h, ffn2_w_gate[l], ffn2_w_up[l], ffn2_w_down[l]), ffn2_post[l])
    return x
```

```cpp
#include <hip/hip_runtime.h>
#include <hip/hip_cooperative_groups.h>
#include <cstdio>
#include <cstdint>
namespace cg = cooperative_groups;

#define LAS __attribute__((address_space(3)))
typedef unsigned short bf16_t;
typedef short bf16x8 __attribute__((ext_vector_type(8)));
typedef short s16x4 __attribute__((ext_vector_type(4)));
typedef float f32x2 __attribute__((ext_vector_type(2)));
typedef float f32x4 __attribute__((ext_vector_type(4)));
typedef float f32x16 __attribute__((ext_vector_type(16)));
typedef unsigned u32x2 __attribute__((ext_vector_type(2)));
typedef unsigned u32x4 __attribute__((ext_vector_type(4)));

constexpr int BATCH = 8, SEQ = 4096, T = BATCH * SEQ, D = 1024, FF = 2816, NGU = 2 * FF;
constexpr int IN_DIM = 5656;
constexpr int PITCH = 3840;
constexpr int C_QN = 0, C_KV = 512, C_DIL = 1280, C_GN = 3584;
constexpr int NCMP = 255;
constexpr int QGP = 576;
constexpr size_t KVN_OFF = (size_t)T * QGP, DILS_OFF = KVN_OFF + (size_t)12 * T * 64;
constexpr float LOG2E = 1.4426950408889634f;
constexpr float RMS_EPS = 1e-6f;

constexpr size_t MiB = 1u << 20;
constexpr size_t WS_WGU1 = 2 * MiB, WS_WD1 = 13 * MiB, WS_WGU2 = 19 * MiB, WS_WD2 = 30 * MiB, WS_WIN = 36 * MiB;
constexpr size_t WS_WGA = 44 * MiB, WS_WGB = 46 * MiB, WS_WN = 48 * MiB, WS_WDIL = 49 * MiB, WS_WMIX = 50 * MiB;
constexpr size_t WS_WCK1 = 52 * MiB, WS_WCV1 = 53 * MiB;
constexpr size_t WS_BIASP = 54 * MiB, WS_KC = 54 * MiB + 0x20000, WS_VC = 54 * MiB + 0xA0000, WS_SELM = 54 * MiB + 0x120000;
constexpr size_t WS_CH = 56 * MiB, WS_H = 60 * MiB, WS_Y = 124 * MiB, WS_BIG = 188 * MiB, WS_ONSA = 428 * MiB, WS_ODIL = 460 * MiB;
constexpr size_t WS_END = 476 * MiB;
constexpr size_t WS_LSE = WS_Y + 48 * MiB;

__device__ __forceinline__ unsigned f2bf(float f) { unsigned u = __builtin_bit_cast(unsigned, f); return (u + 0x7fffu + ((u >> 16) & 1u)) >> 16; }
typedef __bf16 bf16x2_t __attribute__((ext_vector_type(2)));
__device__ __forceinline__ unsigned pk2(float lo, float hi) { f32x2 v = {lo, hi}; return __builtin_bit_cast(unsigned, __builtin_convertvector(v, bf16x2_t)); }
__device__ __forceinline__ float bflo(unsigned w) { return __builtin_bit_cast(float, w << 16); }
__device__ __forceinline__ float bfhi(unsigned w) { return __builtin_bit_cast(float, w & 0xffff0000u); }
__device__ __forceinline__ float sigmoidf_(float x) { return __builtin_amdgcn_rcpf(1.0f + __builtin_amdgcn_exp2f(-1.4426950408889634f * x)); }
__device__ __forceinline__ float wave_sum(float v) {
#pragma unroll
    for (int o = 1; o < 64; o <<= 1) v += __shfl_xor(v, o);
    return v;
}

namespace pg8 {
constexpr int BM = 256, BK = 64, HALF = 128, HTB = HALF * BK * 2, STAGE_BYTES = 8 * HTB, NXCD = 8, WGM = 8;
__host__ __device__ __forceinline__ int lds_byte(int r, int c) { const int st = (r >> 4) * 2 + (c >> 5), rr = r & 15, cc = c & 31, ob = rr * 64 + cc * 2; return st * 1024 + (ob ^ (((ob >> 9) & 1) << 5)); }
__host__ __device__ __forceinline__ void stage_rc(int b, int& R, int& C) { const int st = b / 1024, sb = b % 1024, swz = sb ^ (((sb >> 9) & 1) << 5); R = (st >> 1) * 16 + swz / 64; C = (st & 1) * 32 + (swz % 64) / 2; }
__host__ __device__ __forceinline__ int perm32(int rho) { const int n = rho >> 4, i = rho & 15; return 8 * (i >> 2) + 4 * n + (i & 3); }

struct Unit { int pm, pn; };
struct Gemm { const bf16_t* A; const bf16_t* Bt; int K; int lda; int kstepA; int ldb; };

struct StaticOrder {
    int nM, nN, nwg, G, c; size_t tstepA;
    __device__ void init(int M, int N, int G_, int c_, int lda) { nM = M / BM; nN = N / BM; nwg = nM * nN; G = G_; c = c_; tstepA = (size_t)BM * lda * 2; }
    __device__ bool next(int i, Unit& u) const {
        const long L = (long)i * G + c; if (L >= nwg) return false;
        int wgid = (int)L; { const int q = nwg / NXCD, r = nwg % NXCD, xcd = wgid % NXCD, off = wgid / NXCD; wgid = (xcd < r ? xcd * (q + 1) : r * (q + 1) + (xcd - r) * q) + off; }
        const int nig = WGM * nN, gid = wgid / nig, fm = gid * WGM, gsz = (nM - fm) < WGM ? (nM - fm) : WGM;
        u.pm = fm + ((wgid % nig) % gsz); u.pn = (wgid % nig) / gsz; return true;
    }
    __device__ __forceinline__ size_t aoff(const Unit& u) const { return (size_t)u.pm * tstepA; }
};
struct OneUnit {
    size_t off; int n;
    __device__ bool next(int i, Unit& u) const { if (i >= n) return false; u.pm = 0; u.pn = 0; return true; }
    __device__ __forceinline__ size_t aoff(const Unit&) const { return off; }
};

enum { EP_STORE = 0, EP_SIG = 1, EP_MUL = 2, EP_FINAL = 3, EP_SWIGLU = 4, EP_GELU = 5, EP_PROJ = 6 };
template <int MODE> struct Epi {
    static constexpr bool PERM = true;
    bf16_t* O; int ldc; const bf16_t* P1; const bf16_t* P2; const LAS float* bias;
    __device__ __forceinline__ void operator()(const f32x4 (&acc)[2][2][4][2], const Unit& u, int wr, int wc, int fr, int fq) const {
        const int row0 = u.pm * BM + wr * 64 + fr; const int col0 = u.pn * BM + wc * 32 + 8 * fq;
#pragma unroll
        for (int ai = 0; ai < 2; ++ai)
#pragma unroll
            for (int m = 0; m < 4; ++m) {
                const size_t rbase = (size_t)(row0 + ai * HALF + m * 16);
#pragma unroll
                for (int bj = 0; bj < 2; ++bj) {
                    f32x4 v0 = acc[ai][bj][m][0], v1 = acc[ai][bj][m][1];
                    const int col = col0 + bj * HALF;
                    if (MODE == EP_SWIGLU) {
                        u32x2 w; float r[4];
#pragma unroll
                        for (int e = 0; e < 4; ++e) { const float g = v0[e]; r[e] = g * sigmoidf_(g) * v1[e]; }
                        w.x = pk2(r[0], r[1]); w.y = pk2(r[2], r[3]);
                        *(u32x2*)(O + rbase * ldc + (col >> 1)) = w;
                    } else {
                        float r[8] = {v0[0], v0[1], v0[2], v0[3], v1[0], v1[1], v1[2], v1[3]};
                        size_t off = rbase * ldc + col;
                        if (MODE == EP_PROJ) {
                            const int row = (int)rbase;
                            if (u.pn < 2) off = rbase * QGP + col;
                            else if (u.pn < 5) off = KVN_OFF + ((size_t)((col - 512) >> 6) * T + row) * 64 + (col & 63);
                            else if (u.pn < 14) { const int c2 = col - 1280, slab = c2 >> 6, hd = slab % 12, sh = (hd >> 2) * 2  ;
                                const int sq = row & (SEQ - 1), sp = ((sq & ((1 << sh) - 1)) << (12 - sh)) + (sq >> sh);
                                off = DILS_OFF + ((size_t)slab * T + (row & ~(SEQ - 1)) + sp) * 64 + (col & 63); }
                            else { if (col - 3584 >= 64) continue; off = rbase * QGP + 512 + (col - 3584); }
                        }
                        if (MODE == EP_SIG) {
#pragma unroll
                            for (int e = 0; e < 8; ++e) r[e] = sigmoidf_(r[e]);
                        } else if (MODE == EP_MUL) {
                            const u32x4 p = *(const u32x4*)(P1 + off);
                            r[0] *= bflo(p.x); r[1] *= bfhi(p.x); r[2] *= bflo(p.y); r[3] *= bfhi(p.y); r[4] *= bflo(p.z); r[5] *= bfhi(p.z); r[6] *= bflo(p.w); r[7] *= bfhi(p.w);
                        } else if (MODE == EP_FINAL) {
                            const u32x4 p = *(const u32x4*)(P1 + off); const u32x4 q = *(const u32x4*)(P2 + off);
                            r[0] = bflo(p.x) + bflo(q.x) * r[0]; r[1] = bfhi(p.x) + bfhi(q.x) * r[1]; r[2] = bflo(p.y) + bflo(q.y) * r[2]; r[3] = bfhi(p.y) + bfhi(q.y) * r[3];
                            r[4] = bflo(p.z) + bflo(q.z) * r[4]; r[5] = bfhi(p.z) + bfhi(q.z) * r[5]; r[6] = bflo(p.w) + bflo(q.w) * r[6]; r[7] = bfhi(p.w) + bfhi(q.w) * r[7];
                        } else if (MODE == EP_GELU) {
#pragma unroll
                            for (int e = 0; e < 8; ++e) { const float x = r[e] + bias[col + e]; const float z = 0.7978845608028654f * (x + 0.044715f * x * x * x); r[e] = x * sigmoidf_(2.0f * z); }
                        }
                        u32x4 w; w.x = pk2(r[0], r[1]); w.y = pk2(r[2], r[3]); w.z = pk2(r[4], r[5]); w.w = pk2(r[6], r[7]);
                        *(u32x4*)(O + off) = w;
                    }
                    asm volatile("" ::: "memory");
                }
            }
    }
};

template <class EpiT, class Sched, bool ALIGN_EPI>
__device__ __forceinline__ void gemm_phase(LAS unsigned char* lds, const Gemm g, const Sched& S, const EpiT& E) {
    int tid_ = threadIdx.x; asm volatile("" : "+v"(tid_));
    const int tid = tid_, wid = __builtin_amdgcn_readfirstlane(tid >> 6), lane = tid & 63, wr = wid >> 2, wc = wid & 3, fr = lane & 15, fq = lane >> 4;
    const int K = g.K, nt = K / BK;
    unsigned voffA[2], voffB[2];
#pragma unroll
    for (int i = 0; i < 2; ++i) { int R, C; stage_rc(tid * 16 + i * 8192, R, C); const int Rb = EpiT::PERM ? ((R & ~31) + perm32(R & 31)) : R;
        voffA[i] = (unsigned)(R * g.lda + C) * 2u; voffB[i] = (unsigned)(Rb * g.ldb + C) * 2u; }
    const size_t kstepA = (size_t)g.kstepA, kstepB = (size_t)(BK * 2);
    const size_t hstepA = (size_t)HALF * g.lda * 2, hstepB = (size_t)HALF * g.ldb * 2, tstepB = 2 * hstepB;
    const unsigned ldsw = (unsigned)wid * 1024u;
    const int aoff = lds_byte(wr * 64 + fr, fq * 8), boff = lds_byte(wc * 32 + fr, fq * 8);
#define PG8_SA(b, h) (((b) * 2 + (h)) * HTB)
#define PG8_SB(b, h) ((4 + (b) * 2 + (h)) * HTB)
#define PG8_STAGE(bufoff, gbase, voff) do { _Pragma("unroll") for (int _i = 0; _i < 2; ++_i) \
        __builtin_amdgcn_global_load_lds((const unsigned*)((const char*)(gbase) + (voff)[_i]), (LAS unsigned*)(lds + (bufoff) + ldsw + _i * 8192), 16, 0, 0); } while (0)
#define PG8_LDA(dst, b, h) do { _Pragma("unroll") for (int m = 0; m < 4; ++m) _Pragma("unroll") for (int k = 0; k < 2; ++k) dst[m][k] = *(const LAS bf16x8*)(lds + PG8_SA(b, h) + aoff + m * 2048 + k * 1024); } while (0)
#define PG8_LDB(dst, b, h) do { _Pragma("unroll") for (int n = 0; n < 2; ++n) _Pragma("unroll") for (int k = 0; k < 2; ++k) dst[n][k] = *(const LAS bf16x8*)(lds + PG8_SB(b, h) + boff + n * 2048 + k * 1024); } while (0)
#define PG8_MMA(ai, bj, At, Bt) do { __builtin_amdgcn_s_setprio(1); _Pragma("unroll") for (int m = 0; m < 4; ++m) _Pragma("unroll") for (int n = 0; n < 2; ++n) _Pragma("unroll") for (int k = 0; k < 2; ++k) \
        acc[ai][bj][m][n] = __builtin_amdgcn_mfma_f32_16x16x32_bf16(Bt[n][k], At[m][k], acc[ai][bj][m][n], 0, 0, 0); __builtin_amdgcn_s_setprio(0); } while (0)
#define PG8_WAIT_V(n) asm volatile("s_waitcnt vmcnt(" #n ")" ::: "memory")
#define PG8_WAIT_L(n) asm volatile("s_waitcnt lgkmcnt(" #n ")" ::: "memory")
#define PG8_BAR __builtin_amdgcn_s_barrier()
#define PG8_SCHED __builtin_amdgcn_sched_barrier(0)
    Unit cur, nxt; int ui = 0;
    if (!S.next(0, cur)) return;
    f32x4 acc[2][2][4][2];
#pragma unroll
    for (int a = 0; a < 2; ++a)
#pragma unroll
        for (int b = 0; b < 2; ++b)
#pragma unroll
            for (int m = 0; m < 4; ++m)
#pragma unroll
                for (int n = 0; n < 2; ++n) acc[a][b][m][n] = (f32x4){0.f, 0.f, 0.f, 0.f};
    bf16x8 At[4][2], B0[2][2], B1[2][2];
    const char* cA = (const char*)g.A + S.aoff(cur); const char* cB = (const char*)g.Bt + (size_t)cur.pn * tstepB;
    PG8_STAGE(PG8_SB(0, 0), cB, voffB); PG8_STAGE(PG8_SB(0, 1), cB + hstepB, voffB); PG8_STAGE(PG8_SA(0, 0), cA, voffA); PG8_STAGE(PG8_SA(0, 1), cA + hstepA, voffA);
    if (wr == 1) PG8_BAR;
    PG8_WAIT_V(2); PG8_BAR;
    PG8_STAGE(PG8_SB(1, 0), cB + kstepB, voffB); PG8_STAGE(PG8_SA(1, 0), cA + kstepA, voffA); PG8_STAGE(PG8_SB(1, 1), cB + hstepB + kstepB, voffB);
    PG8_WAIT_V(6); PG8_BAR;
    for (;;) {
        const bool has_next = S.next(ui + 1, nxt);
        const char* nA = has_next ? (const char*)g.A + S.aoff(nxt) : cA; const char* nB = has_next ? (const char*)g.Bt + (size_t)nxt.pn * tstepB : cB;
        for (int t = 0; t < nt; t += 2) {
            const bool last = (t == nt - 2);
            const char* a1 = cA + (size_t)(t + 1) * kstepA;
            const char* a2 = last ? nA : cA + (size_t)(t + 2) * kstepA; const char* b2 = last ? nB : cB + (size_t)(t + 2) * kstepB;
            const char* a3 = a2 + kstepA; const char* b3 = b2 + kstepB;
            PG8_LDB(B0, 0, 0); PG8_LDB(B1, 0, 1); PG8_SCHED; PG8_LDA(At, 0, 0); PG8_STAGE(PG8_SA(1, 1), a1 + hstepA, voffA);
            PG8_WAIT_V(8); PG8_WAIT_L(0); PG8_BAR; PG8_MMA(0, 0, At, B0); PG8_MMA(0, 1, At, B1); PG8_BAR; PG8_SCHED;
            PG8_LDA(At, 0, 1); PG8_STAGE(PG8_SB(0, 0), b2, voffB); PG8_STAGE(PG8_SB(0, 1), b2 + hstepB, voffB); PG8_STAGE(PG8_SA(0, 0), a2, voffA);
            PG8_WAIT_V(8); PG8_WAIT_L(0); PG8_BAR; PG8_MMA(1, 0, At, B0); PG8_MMA(1, 1, At, B1); PG8_BAR; PG8_SCHED;
            PG8_LDB(B0, 1, 0); PG8_LDB(B1, 1, 1); PG8_SCHED; PG8_LDA(At, 1, 0); PG8_STAGE(PG8_SA(0, 1), a2 + hstepA, voffA);
            PG8_WAIT_V(8); PG8_WAIT_L(0); PG8_BAR; PG8_MMA(0, 0, At, B0); PG8_MMA(0, 1, At, B1); PG8_BAR; PG8_SCHED;
            PG8_LDA(At, 1, 1); PG8_STAGE(PG8_SB(1, 0), b3, voffB); PG8_STAGE(PG8_SB(1, 1), b3 + hstepB, voffB); PG8_STAGE(PG8_SA(1, 0), a3, voffA);
            PG8_WAIT_V(8); PG8_WAIT_L(0); PG8_BAR; PG8_MMA(1, 0, At, B0); PG8_MMA(1, 1, At, B1); PG8_BAR; PG8_SCHED;
        }
        if constexpr (ALIGN_EPI) { if (wr == 0) PG8_BAR; }
        E(acc, cur, wr, wc, fr, fq);
        if (!has_next) break;
#pragma unroll
        for (int a = 0; a < 2; ++a)
#pragma unroll
            for (int b = 0; b < 2; ++b)
#pragma unroll
                for (int m = 0; m < 4; ++m)
#pragma unroll
                    for (int n = 0; n < 2; ++n) acc[a][b][m][n] = (f32x4){0.f, 0.f, 0.f, 0.f};
        cur = nxt; cA = nA; cB = nB; ++ui;
        if constexpr (ALIGN_EPI) { if (wr == 1) PG8_BAR; }
    }
    PG8_WAIT_V(0);
    if constexpr (!ALIGN_EPI) { if (wr == 0) PG8_BAR; }
    PG8_BAR;
#undef PG8_SA
#undef PG8_SB
#undef PG8_STAGE
#undef PG8_LDA
#undef PG8_LDB
#undef PG8_MMA
#undef PG8_WAIT_V
#undef PG8_WAIT_L
#undef PG8_BAR
#undef PG8_SCHED
}
}

struct Args { const float* in[23]; float* out; unsigned char* ws; int ph_lo, ph_hi; };

enum { W_GU1 = 0, W_D1, W_GU2, W_D2, W_IN, W_GA, W_GB, W_N, W_DIL, W_MIX, W_CK1, W_CV1, W_CK2, W_CV2, W_NMAT };
struct MatDesc { int K, Nd; size_t wsoff; };
__device__ __forceinline__ MatDesc mat_desc(int m) {
    switch (m) {
        case W_GU1: return {D, NGU, WS_WGU1};
        case W_D1: return {FF, D, WS_WD1};
        case W_GU2: return {D, NGU, WS_WGU2};
        case W_D2: return {FF, D, WS_WD2};
        case W_IN: return {D, PITCH, WS_WIN};
        case W_GA: return {D, D, WS_WGA};
        case W_GB: return {D, D, WS_WGB};
        case W_N: return {512, D, WS_WN};
        case W_DIL: return {256, D, WS_WDIL};
        case W_MIX: return {D, D, WS_WMIX};
        case W_CK1: return {2048, 256, WS_WCK1};
        case W_CV1: return {2048, 256, WS_WCV1};
        case W_CK2: return {256, 64, WS_SELM};
        default: return {256, 64, WS_SELM + 0x8000};
    }
}
__device__ __forceinline__ const float* mat_src(const Args& a, int m, int n, int& ldw) {
    switch (m) {
        case W_GU1: case W_GU2: { ldw = FF; const int c = (n >> 3) * 4 + (n & 3); const int gi = (m == W_GU1) ? 3 : 20; return ((n & 4) ? a.in[gi + 1] : a.in[gi]) + c; }
        case W_D1: ldw = D; return a.in[5] + n;
        case W_D2: ldw = D; return a.in[22] + n;
        case W_IN: { ldw = IN_DIM; int c; if (n < 1280) c = n; else if (n < 3584) c = n + 24; else if (n < 3608) c = n - 3584 + 1280; else return nullptr; return a.in[8] + c; }
        case W_GA: ldw = IN_DIM; return a.in[8] + 3608 + n;
        case W_GB: ldw = IN_DIM; return a.in[8] + 4632 + n;
        case W_N: ldw = D; return a.in[15] + n;
        case W_DIL: ldw = D; return a.in[16] + n;
        case W_MIX: ldw = D; return a.in[17] + n;
        case W_CK1: ldw = 256; return a.in[10] + n;
        case W_CV1: ldw = 256; return a.in[13] + n;
        case W_CK2: ldw = 64; return a.in[11] + n;
        default: ldw = 64; return a.in[14] + n;
    }
}
__device__ __forceinline__ void transpose_item(const Args& a, int m, int item, int lane) {
    const MatDesc md = mat_desc(m);
    const int nblk = md.Nd / 64, kb = item / nblk, nb = item % nblk, k0 = 64 * kb, n0 = 64 * nb;
    int ldw = 0; const float* src = mat_src(a, m, n0 + lane, ldw);
    float v[64];
    if (src) {
        const float* p = src + (size_t)k0 * ldw;
#pragma unroll
        for (int kk = 0; kk < 64; ++kk) v[kk] = p[(size_t)kk * ldw];
    } else {
#pragma unroll
        for (int kk = 0; kk < 64; ++kk) v[kk] = 0.f;
    }
    u32x4* dst = (u32x4*)((bf16_t*)(a.ws + md.wsoff) + (size_t)(n0 + lane) * md.K + k0);
#pragma unroll
    for (int c = 0; c < 8; ++c) { u32x4 o; o.x = pk2(v[8 * c], v[8 * c + 1]); o.y = pk2(v[8 * c + 2], v[8 * c + 3]); o.z = pk2(v[8 * c + 4], v[8 * c + 5]); o.w = pk2(v[8 * c + 6], v[8 * c + 7]); dst[c] = o; }
}

template <bool XIN16, bool XO16>
__device__ __forceinline__ void row_pass(const void* xin_, const bf16_t* y, float scale, const float* gpost, void* xo_, const float* gnext, bf16_t* hout, int gw, int ngw, int lane) {
    const float* xin = (const float*)xin_; const bf16_t* xin16 = (const bf16_t*)xin_; float* xo = (float*)xo_; bf16_t* xo16 = (bf16_t*)xo_;
    f32x4 nv[4]; u32x2 ny[4];
#pragma unroll
    for (int j = 0; j < 4; ++j) { nv[j] = (f32x4){0.f, 0.f, 0.f, 0.f}; ny[j] = (u32x2){0u, 0u}; }
    if (gw < T) {
        if (XIN16) { const u32x2* xr = (const u32x2*)(xin16 + (size_t)gw * D) + lane;
#pragma unroll
            for (int j = 0; j < 4; ++j) { const u32x2 w = xr[64 * j]; nv[j] = (f32x4){bflo(w.x), bfhi(w.x), bflo(w.y), bfhi(w.y)}; } }
        else { const f32x4* xr = (const f32x4*)(xin + (size_t)gw * D) + lane;
#pragma unroll
            for (int j = 0; j < 4; ++j) nv[j] = xr[64 * j]; }
        if (y) { const u32x2* yr = (const u32x2*)(y + (size_t)gw * D) + lane;
#pragma unroll
            for (int j = 0; j < 4; ++j) ny[j] = yr[64 * j]; }
    }
    for (int m = gw; m < T; m += ngw) {
        f32x4 v[4]; u32x2 yw[4];
#pragma unroll
        for (int j = 0; j < 4; ++j) { v[j] = nv[j]; yw[j] = ny[j]; }
        const int mn = m + ngw;
        if (mn < T) {
            if (XIN16) { const u32x2* xr = (const u32x2*)(xin16 + (size_t)mn * D) + lane;
#pragma unroll
                for (int j = 0; j < 4; ++j) { const u32x2 w = xr[64 * j]; nv[j] = (f32x4){bflo(w.x), bfhi(w.x), bflo(w.y), bfhi(w.y)}; } }
            else { const f32x4* xr = (const f32x4*)(xin + (size_t)mn * D) + lane;
#pragma unroll
                for (int j = 0; j < 4; ++j) nv[j] = xr[64 * j]; }
            if (y) { const u32x2* yr = (const u32x2*)(y + (size_t)mn * D) + lane;
#pragma unroll
                for (int j = 0; j < 4; ++j) ny[j] = yr[64 * j]; }
        }
        if (y) {
            f32x4 yv[4]; float s = 0.f;
#pragma unroll
            for (int j = 0; j < 4; ++j) { const u32x2 w = yw[j]; yv[j] = (f32x4){bflo(w.x), bfhi(w.x), bflo(w.y), bfhi(w.y)}; s += (yv[j].x * yv[j].x + yv[j].y * yv[j].y) + (yv[j].z * yv[j].z + yv[j].w * yv[j].w); }
            const float rs = rsqrtf(wave_sum(s) * (1.f / D) + RMS_EPS) * scale;
#pragma unroll
            for (int j = 0; j < 4; ++j) { const f32x4 g = ((const f32x4*)gpost)[lane + 64 * j]; v[j] = v[j] + yv[j] * rs * g; }
            if (XO16) { u32x2* xw = (u32x2*)(xo16 + (size_t)m * D) + lane;
#pragma unroll
                for (int j = 0; j < 4; ++j) { u32x2 w; w.x = pk2(v[j].x, v[j].y); w.y = pk2(v[j].z, v[j].w); xw[64 * j] = w; } }
            else { f32x4* xw = (f32x4*)(xo + (size_t)m * D) + lane;
#pragma unroll
                for (int j = 0; j < 4; ++j) xw[64 * j] = v[j]; }
        }
        if (hout) {
            float s = 0.f;
#pragma unroll
            for (int j = 0; j < 4; ++j) s += (v[j].x * v[j].x + v[j].y * v[j].y) + (v[j].z * v[j].z + v[j].w * v[j].w);
            const float rs = rsqrtf(wave_sum(s) * (1.f / D) + RMS_EPS);
            u32x2* hw = (u32x2*)(hout + (size_t)m * D) + lane;
#pragma unroll
            for (int j = 0; j < 4; ++j) { const f32x4 g = ((const f32x4*)gnext)[lane + 64 * j]; const f32x4 o = v[j] * rs * g; u32x2 w; w.x = pk2(o.x, o.y); w.y = pk2(o.z, o.w); hw[64 * j] = w; }
        }
    }
}

constexpr int KP = 144, VP = 192;
constexpr int KST = 64 * KP, VST = 64 * VP;
constexpr int ATT_K0 = 0, ATT_V0 = 2 * KST;
constexpr int ATT_MISC = ATT_V0 + 2 * VST;
constexpr int ATT_SELL = ATT_MISC + 128;
constexpr int ATT_IMP = 44032;
constexpr int ATT_ACC = 110592;
enum { AT_BAND = 0, AT_CMP = 1, AT_SEL = 2 };
enum { MD_ONLINE = 0, MD_STATS = 1, MD_NORM = 2 };

__device__ __forceinline__ s16x4 tr16(const LAS unsigned char* p) {
    return __builtin_bit_cast(s16x4, __builtin_amdgcn_ds_read_tr16_b64_v4i16((LAS s16x4*)p));
}
__device__ __forceinline__ float xhalf_max(float m) {
    auto rr = __builtin_amdgcn_permlane32_swap(__builtin_bit_cast(unsigned, m), __builtin_bit_cast(unsigned, m), false, false);
    return fmaxf(__builtin_bit_cast(float, rr[0]), __builtin_bit_cast(float, rr[1]));
}

struct AttnWave {
    bf16x8 qf[4];
    f32x16 o[2];
    float kb[16];
    float m, l;
    int iq, i0w;
    int jlo, jhi;
    float c1, sb;
    int j0;
    int max_back;
    unsigned long long mysel;
    float mfin, invl;
    bool started;
};

template <int TYPE, int MODE>
__device__ __forceinline__ void attn_stage(AttnWave& W, const LAS unsigned char* Kl, const LAS unsigned char* Vl, int cur, int lane, LAS float* imp  , bool wave_skip_sel) {
    const int r32 = lane & 31, h = lane >> 5;
    const int jt = 64 * cur;
    {
        bool skip = (jt + 63 < W.jlo) || (jt > W.jhi);
        if (TYPE == AT_SEL) skip = skip || wave_skip_sel;
        if (TYPE == AT_CMP && MODE == MD_NORM) skip = false;
        if (skip) return;
    }
    bool lane_on = true;
    if (TYPE == AT_SEL) lane_on = ((W.mysel >> cur) & 1ull) != 0ull;
    const float ref = (MODE == MD_NORM) ? W.mfin : W.m;
    float base0 = W.sb * (float)(jt - W.j0) - ref;
    if (TYPE == AT_SEL) base0 = lane_on ? base0 : -INFINITY;
    const float base1 = base0 + 32.0f * W.sb;
    f32x16 s0, s1;
#pragma unroll
    for (int r = 0; r < 16; ++r) { s0[r] = W.kb[r] + base0; s1[r] = W.kb[r] + base1; }
    const LAS unsigned char* kp = Kl + r32 * KP + h * 16;
    bf16x8 kf0[4], kf1[4];
#pragma unroll
    for (int ds = 0; ds < 4; ++ds) { kf0[ds] = *(const LAS bf16x8*)(kp + ds * 32); kf1[ds] = *(const LAS bf16x8*)(kp + 32 * KP + ds * 32); }
    __builtin_amdgcn_sched_barrier(0);
#pragma unroll
    for (int ds = 0; ds < 4; ++ds) {
        s0 = __builtin_amdgcn_mfma_f32_32x32x16_bf16(kf0[ds], W.qf[ds], s0, 0, 0, 0);
        s1 = __builtin_amdgcn_mfma_f32_32x32x16_bf16(kf1[ds], W.qf[ds], s1, 0, 0, 0);
    }
    const LAS unsigned char* vp = Vl + (4 * h + ((lane & 15) >> 2)) * VP + (16 * ((lane >> 4) & 1) + 4 * (lane & 3)) * 2;
    s16x4 vlo[4][2], vhi[4][2];
    if (MODE != MD_STATS) {
#pragma unroll
        for (int s4 = 0; s4 < 4; ++s4)
#pragma unroll
            for (int blk = 0; blk < 2; ++blk) { vlo[s4][blk] = tr16(vp + (16 * s4) * VP + blk * 64); vhi[s4][blk] = tr16(vp + (16 * s4 + 8) * VP + blk * 64); }
    }
    __builtin_amdgcn_sched_barrier(0);
    float x0[16], x1[16];
#pragma unroll
    for (int r = 0; r < 16; ++r) { x0[r] = s0[r]; x1[r] = s1[r]; }
    if (TYPE == AT_BAND) {
        const bool interior = (jt + 63 <= W.i0w) && (W.i0w + 31 - jt <= W.max_back);
        if (!interior) {
            const int d = W.iq - jt - 4 * h;
#pragma unroll
            for (int r = 0; r < 16; ++r) { const int cr = (r & 3) + 8 * (r >> 2);
                x0[r] = ((unsigned)(d - cr) <= (unsigned)W.max_back) ? x0[r] : -INFINITY;
                x1[r] = ((unsigned)(d - 32 - cr) <= (unsigned)W.max_back) ? x1[r] : -INFINITY; }
        }
    } else if (TYPE == AT_CMP) {
        int lim = (W.iq - 31) >> 4; lim = lim > NCMP - 1 ? NCMP - 1 : lim; lim -= jt + 4 * h;
#pragma unroll
        for (int r = 0; r < 16; ++r) { const int cr = (r & 3) + 8 * (r >> 2); x0[r] = (cr <= lim) ? x0[r] : -INFINITY; x1[r] = (cr + 32 <= lim) ? x1[r] : -INFINITY; }
    } else {
        if (jt + 63 > W.i0w) {
            const int d = W.iq - jt - 4 * h;
#pragma unroll
            for (int r = 0; r < 16; ++r) { const int cr = (r & 3) + 8 * (r >> 2); x0[r] = (cr <= d) ? x0[r] : -INFINITY; x1[r] = (cr + 32 <= d) ? x1[r] : -INFINITY; }
        }
    }
    float p0[16], p1[16];
    if (MODE != MD_NORM) {
        float ma = fmaxf(fmaxf(x0[0], x0[1]), fmaxf(x0[2], x0[3])), mb = fmaxf(fmaxf(x1[0], x1[1]), fmaxf(x1[2], x1[3]));
#pragma unroll
        for (int r = 4; r < 16; r += 4) { ma = fmaxf(ma, fmaxf(fmaxf(x0[r], x0[r + 1]), fmaxf(x0[r + 2], x0[r + 3]))); mb = fmaxf(mb, fmaxf(fmaxf(x1[r], x1[r + 1]), fmaxf(x1[r + 2], x1[r + 3]))); }
        const float gmx = xhalf_max(fmaxf(ma, mb));
        const bool need = W.started ? (gmx > 60.0f) : (gmx > -INFINITY);
        if (__builtin_amdgcn_ballot_w64(need) != 0ull) {
            const float delta = need ? gmx : 0.f;
            const float f = W.started ? __builtin_amdgcn_exp2f(-delta) : 1.0f;
            W.m += delta; W.started = W.started || need;
            W.l *= f;
#pragma unroll
            for (int r = 0; r < 16; ++r) { x0[r] -= delta; x1[r] -= delta; }
            if (MODE == MD_ONLINE) {
#pragma unroll
                for (int r = 0; r < 16; ++r) { W.o[0][r] *= f; W.o[1][r] *= f; }
            }
        }
        float lsa = 0.f, lsb = 0.f;
#pragma unroll
        for (int r = 0; r < 16; ++r) { p0[r] = __builtin_amdgcn_exp2f(x0[r]); lsa += p0[r]; p1[r] = __builtin_amdgcn_exp2f(x1[r]); lsb += p1[r]; }
        W.l += lsa + lsb;
    } else {
#pragma unroll
        for (int r = 0; r < 16; ++r) { p0[r] = __builtin_amdgcn_exp2f(x0[r]) * W.invl; p1[r] = __builtin_amdgcn_exp2f(x1[r]) * W.invl; }
    }
    if (TYPE == AT_CMP && MODE == MD_NORM) {
#pragma unroll
        for (int hf = 0; hf < 2; ++hf)
#pragma unroll
            for (int i = 0; i < 4; ++i) {
                const float q0 = hf ? p1[4 * i] : p0[4 * i], q1 = hf ? p1[4 * i + 1] : p0[4 * i + 1], q2 = hf ? p1[4 * i + 2] : p0[4 * i + 2], q3 = hf ? p1[4 * i + 3] : p0[4 * i + 3];
                const float Bv = 0.5f * q3;
                const float A = (q0 + q1) + (q2 + Bv);
                const int u = 8 * (2 * cur + hf) + 2 * i + h;
                imp[u] += A;
                asm volatile("" ::: "memory");
                imp[u + 1] += Bv;
                asm volatile("" ::: "memory");
            }
    }
    if (MODE != MD_STATS) {
        bf16x8 pb[4];
#pragma unroll
        for (int s2 = 0; s2 < 2; ++s2) {
            u32x4 w; w.x = pk2(p0[8 * s2 + 0], p0[8 * s2 + 1]); w.y = pk2(p0[8 * s2 + 2], p0[8 * s2 + 3]); w.z = pk2(p0[8 * s2 + 4], p0[8 * s2 + 5]); w.w = pk2(p0[8 * s2 + 6], p0[8 * s2 + 7]);
            pb[s2] = __builtin_bit_cast(bf16x8, w);
            u32x4 z; z.x = pk2(p1[8 * s2 + 0], p1[8 * s2 + 1]); z.y = pk2(p1[8 * s2 + 2], p1[8 * s2 + 3]); z.z = pk2(p1[8 * s2 + 4], p1[8 * s2 + 5]); z.w = pk2(p1[8 * s2 + 6], p1[8 * s2 + 7]);
            pb[2 + s2] = __builtin_bit_cast(bf16x8, z);
        }
#pragma unroll
        for (int s4 = 0; s4 < 4; ++s4) {
#pragma unroll
            for (int blk = 0; blk < 2; ++blk) {
                const s16x4 lo = vlo[s4][blk], hi = vhi[s4][blk];
                const bf16x8 vf = (bf16x8){lo[0], lo[1], lo[2], lo[3], hi[0], hi[1], hi[2], hi[3]};
                W.o[blk] = __builtin_amdgcn_mfma_f32_32x32x16_bf16(vf, pb[s4], W.o[blk], 0, 0, 0);
            }
        }
    }
}

struct AttnUnitDesc {
    const bf16_t* K; const bf16_t* V; long kvstride; int jclamp;
    unsigned long long stmask;
};

template <int TYPE, int MODE>
__device__ __forceinline__ void attn_run(AttnWave& W, const AttnUnitDesc& U, LAS unsigned char* lds, int tid, int lane, LAS float* imp, unsigned long long wavemask) {
    const int srow = tid >> 3, sch = tid & 7;
    unsigned long long rem = U.stmask;
    int cur = 63 - __builtin_clzll(rem); rem &= ~(1ull << cur);
    u32x4 kreg, vreg;
    { int j = 64 * cur + srow; j = j > U.jclamp ? U.jclamp : j; const size_t off = (size_t)j * U.kvstride + sch * 8; kreg = *(const u32x4*)(U.K + off); vreg = *(const u32x4*)(U.V + off); }
    int buf = 0;
    *(LAS u32x4*)(lds + ATT_K0 + srow * KP + sch * 16) = kreg; *(LAS u32x4*)(lds + ATT_V0 + srow * VP + sch * 16) = vreg;
    __syncthreads();
    for (;;) {
        int nxt = -1;
        if (rem) { nxt = 63 - __builtin_clzll(rem); rem &= ~(1ull << nxt);
            int j = 64 * nxt + srow; j = j > U.jclamp ? U.jclamp : j; const size_t off = (size_t)j * U.kvstride + sch * 8; kreg = *(const u32x4*)(U.K + off); vreg = *(const u32x4*)(U.V + off); }
        const bool wskip = (TYPE == AT_SEL) ? (((wavemask >> cur) & 1ull) == 0ull) : false;
        attn_stage<TYPE, MODE>(W, lds + ATT_K0 + buf * KST, lds + ATT_V0 + buf * VST, cur, lane, imp, wskip);
        if (nxt < 0) break;
        *(LAS u32x4*)(lds + ATT_K0 + (buf ^ 1) * KST + srow * KP + sch * 16) = kreg; *(LAS u32x4*)(lds + ATT_V0 + (buf ^ 1) * VST + srow * VP + sch * 16) = vreg;
        __syncthreads();
        buf ^= 1; cur = nxt;
    }
    __syncthreads();
}

__device__ __forceinline__ void attn_init(AttnWave& W, int lane, int i0w, float slope_l2, int dstep) {
#pragma unroll
    for (int r = 0; r < 16; ++r) { W.o[0][r] = 0.f; W.o[1][r] = 0.f; }
    W.m = 0.f; W.l = 0.f; W.mysel = 0ull; W.mfin = 0.f; W.invl = 0.f; W.max_back = 0; W.started = false;
    W.i0w = i0w; W.iq = i0w + (lane & 31); W.c1 = 0.125f * LOG2E; W.sb = slope_l2 * (float)dstep;
#pragma unroll
    for (int r = 0; r < 16; ++r) W.kb[r] = W.sb * (float)((r & 3) + 8 * (r >> 2) + 4 * (lane >> 5));
}
__device__ __forceinline__ void load_q(AttnWave& W, const bf16_t* Qw, long qstride, int lane) {
    const int r32 = lane & 31, h = lane >> 5;
#pragma unroll
    for (int ds = 0; ds < 4; ++ds) {
        const u32x4 w = *(const u32x4*)(Qw + (size_t)r32 * qstride + 16 * ds + 8 * h); const float c = W.c1;
        u32x4 o; o.x = pk2(bflo(w.x) * c, bfhi(w.x) * c); o.y = pk2(bflo(w.y) * c, bfhi(w.y) * c); o.z = pk2(bflo(w.z) * c, bfhi(w.z) * c); o.w = pk2(bflo(w.w) * c, bfhi(w.w) * c);
        W.qf[ds] = __builtin_bit_cast(bf16x8, o);
    }
}

__device__ __forceinline__ float nsa_slope(int head) { return exp2f(-(float)(head + 1)); }
__device__ __forceinline__ void gqa_decode(int u, int& b, int& g, int& qb) {
    const int low6 = u & 63, hi4 = u >> 6, k = hi4 >> 2; b = hi4 >> 1; g = hi4 & 1;
    const int base = (low6 + 32 * (k >> 1)) & 63; qb = (k & 1) ? 63 - base : base;
}

__device__ __forceinline__ void unit_dilated(const Args& a, int id, LAS unsigned char* lds, int tid, int wid, int lane) {
    const int grp = id >> 9, rem = id & 511, b = rem >> 6, hi = (rem >> 4) & 3, sub = rem & 15;
    const int dil = grp == 0 ? 1 : (grp == 1 ? 4 : 16);
    const int r = sub % dil, ublk = sub / dil;
    const bf16_t* proj = (const bf16_t*)(a.ws + WS_BIG) + DILS_OFF + ((size_t)(4 * grp + hi) * T + (size_t)b * SEQ + (size_t)r * (SEQ / dil)) * 64;
    const long stride = 64;
    const int i0w = 256 * ublk + 32 * wid;
    const float slope = exp2f(-8.0f * (float)(4 * grp + hi + 1) / 12.0f);
    AttnWave W; attn_init(W, lane, i0w, slope * LOG2E, dil);
    load_q(W, proj + (size_t)i0w * stride, stride, lane);
    W.jlo = i0w - 128; W.jhi = i0w + 31; W.max_back = 128;
    const int slo = ublk > 0 ? 4 * ublk - 2 : 0, shi = 4 * ublk + 3; W.j0 = 64 * shi;
    AttnUnitDesc U; U.K = proj + (size_t)12 * T * 64; U.V = proj + (size_t)24 * T * 64; U.kvstride = stride; U.jclamp = SEQ / dil - 1;
    U.stmask = ((shi == 63) ? ~0ull : ((2ull << shi) - 1ull)) & ~((1ull << slo) - 1ull);
    attn_run<AT_BAND, MD_ONLINE>(W, U, lds, tid, lane, nullptr, 0ull);
    const float lt = W.l + __shfl_xor(W.l, 32); const float inv = 1.0f / fmaxf(lt, 1e-30f);
    const size_t tok = (size_t)b * SEQ + (size_t)dil * W.iq + r;
    bf16_t* orow = (bf16_t*)(a.ws + WS_Y) + ((size_t)grp * T + tok) * 256 + hi * 64;
    const int h = lane >> 5;
#pragma unroll
    for (int blk = 0; blk < 2; ++blk)
#pragma unroll
        for (int i = 0; i < 4; ++i) { u32x2 w; w.x = pk2(W.o[blk][4 * i] * inv, W.o[blk][4 * i + 1] * inv); w.y = pk2(W.o[blk][4 * i + 2] * inv, W.o[blk][4 * i + 3] * inv);
            *(u32x2*)(orow + 32 * blk + 8 * i + 4 * h) = w; }
    if (h == 0) ((float*)(a.ws + WS_LSE))[((size_t)grp * T + tok) * 4 + hi] = (W.m + __log2f(lt) - W.sb * (float)(W.iq - W.j0)) * 0.6931471805599453f;
}

__device__ __forceinline__ void unit_nsa(const Args& a, int b, int g, int qb, LAS unsigned char* lds, int tid, int wid, int lane) {
    const bf16_t* big = (const bf16_t*)(a.ws + WS_BIG);
    const bf16_t* kvn = big + KVN_OFF + (size_t)b * SEQ * 64;
    const int hl = wid >> 1, head = g * 4 + hl, i0w = 64 * qb + 32 * (wid & 1);
    const float sl2 = nsa_slope(head) * LOG2E;
    LAS float* IMP = (LAS float*)(lds + ATT_IMP);
    for (int i = tid; i < 4 * 64 * 65; i += 512) IMP[i] = 0.f;
    const size_t tok = (size_t)b * SEQ + i0w + (lane & 31);
    const bf16_t* gp = big + tok * QGP + 512 + head * 3;
    const float g0 = sigmoidf_(bflo((unsigned)gp[0])), g1 = sigmoidf_(bflo((unsigned)gp[1])), g2 = sigmoidf_(bflo((unsigned)gp[2]));
    AttnWave W; AttnUnitDesc U;
    LAS u32x2* accl = (LAS u32x2*)(lds + ATT_ACC + wid * 4096) + lane;
    attn_init(W, lane, i0w, sl2, 1);
    load_q(W, big + ((size_t)b * SEQ + i0w) * QGP + head * 64, QGP, lane);
    {
        W.jlo = i0w - 511; W.jhi = i0w + 31; W.max_back = 511;
        const int slo = qb >= 8 ? qb - 8 : 0; W.j0 = 64 * qb;
        U.K = kvn + (size_t)(8 + g) * T * 64; U.V = kvn + (size_t)(10 + g) * T * 64; U.kvstride = 64; U.jclamp = SEQ - 1;
        U.stmask = ((qb == 63) ? ~0ull : ((2ull << qb) - 1ull)) & ~((1ull << slo) - 1ull);
        attn_run<AT_BAND, MD_ONLINE>(W, U, lds, tid, lane, nullptr, 0ull);
        const float lt = W.l + __shfl_xor(W.l, 32); const float sc = g2 / fmaxf(lt, 1e-30f);
#pragma unroll
        for (int blk = 0; blk < 2; ++blk)
#pragma unroll
            for (int i = 0; i < 4; ++i) { u32x2 w; w.x = pk2(W.o[blk][4 * i] * sc, W.o[blk][4 * i + 1] * sc); w.y = pk2(W.o[blk][4 * i + 2] * sc, W.o[blk][4 * i + 3] * sc); accl[(blk * 4 + i) * 64] = w; }
    }
    attn_init(W, lane, i0w, sl2, 16);
    {
        W.jlo = 0; W.jhi = i0w >> 4;
        const int cmax = 4 * qb + 2, shi = cmax >> 6; W.j0 = 64 * shi;
        U.K = (const bf16_t*)(a.ws + WS_KC) + (size_t)(b * 2 + g) * 256 * 64; U.V = (const bf16_t*)(a.ws + WS_VC) + (size_t)(b * 2 + g) * 256 * 64; U.kvstride = 64; U.jclamp = NCMP - 1;
        U.stmask = (2ull << shi) - 1ull;
        LAS float* impw = IMP + ((size_t)hl * 64 + 32 * (wid & 1) + (lane & 31)) * 65;
        attn_run<AT_CMP, MD_STATS>(W, U, lds, tid, lane, impw, 0ull);
        const float lt = W.l + __shfl_xor(W.l, 32);
        W.mfin = W.m; W.invl = 1.0f / fmaxf(lt, 1e-30f);
        attn_run<AT_CMP, MD_NORM>(W, U, lds, tid, lane, impw, 0ull);
#pragma unroll
        for (int blk = 0; blk < 2; ++blk)
#pragma unroll
            for (int i = 0; i < 4; ++i) { const u32x2 p = accl[(blk * 4 + i) * 64]; u32x2 w;
                w.x = pk2(bflo(p.x) + W.o[blk][4 * i] * g0, bfhi(p.x) + W.o[blk][4 * i + 1] * g0); w.y = pk2(bflo(p.y) + W.o[blk][4 * i + 2] * g0, bfhi(p.y) + W.o[blk][4 * i + 3] * g0); accl[(blk * 4 + i) * 64] = w; }
    }
    LAS unsigned long long* SELL = (LAS unsigned long long*)(lds + ATT_SELL);
    for (int qq = 8 * wid; qq < 8 * wid + 8; ++qq) {
        float val = ((IMP[(0 * 64 + qq) * 65 + lane] + IMP[(1 * 64 + qq) * 65 + lane]) + IMP[(2 * 64 + qq) * 65 + lane]) + IMP[(3 * 64 + qq) * 65 + lane];
        const int own = qb, j = lane;
        const bool forced = (j == 0) || (j == own) || (j == own - 1);
        const bool valid = j <= own;
        val = forced ? INFINITY : (valid ? val : -INFINITY);
        int rank = 0;
#pragma unroll
        for (int jj = 0; jj < 64; ++jj) { const float o = __builtin_bit_cast(float, __builtin_amdgcn_readlane(__builtin_bit_cast(int, val), jj)); rank += (o > val || (o == val && jj < j)) ? 1 : 0; }
        const unsigned long long msk = __ballot(rank < 16);
        if (lane == 0) SELL[qq] = msk;
    }
    __syncthreads();
    attn_init(W, lane, i0w, sl2, 1);
    {
        W.jlo = 0; W.jhi = i0w + 31; W.j0 = 64 * qb;
        W.mysel = SELL[32 * (wid & 1) + (lane & 31)];
        unsigned lo = (unsigned)W.mysel, hi = (unsigned)(W.mysel >> 32);
#pragma unroll
        for (int o = 1; o < 64; o <<= 1) { lo |= __shfl_xor(lo, o); hi |= __shfl_xor(hi, o); }
        const unsigned long long wm = ((unsigned long long)hi << 32) | lo;
        unsigned long long um = 0ull;
#pragma unroll
        for (int q = 0; q < 64; ++q) um |= SELL[q];
        const unsigned long long causal = (qb == 63) ? ~0ull : ((2ull << qb) - 1ull);
        um &= causal; um |= 1ull;
        U.K = kvn + (size_t)(4 + g) * T * 64; U.V = kvn + (size_t)(6 + g) * T * 64; U.kvstride = 64; U.jclamp = SEQ - 1; U.stmask = um;
        attn_run<AT_SEL, MD_ONLINE>(W, U, lds, tid, lane, nullptr, wm);
        const float lt = W.l + __shfl_xor(W.l, 32); const float sc = g1 / fmaxf(lt, 1e-30f);
        bf16_t* orow = (bf16_t*)(a.ws + WS_ONSA) + tok * 512 + head * 64;
        const int h = lane >> 5;
#pragma unroll
        for (int blk = 0; blk < 2; ++blk)
#pragma unroll
            for (int i = 0; i < 4; ++i) { const u32x2 p = accl[(blk * 4 + i) * 64]; u32x2 w;
                w.x = pk2(bflo(p.x) + W.o[blk][4 * i] * sc, bfhi(p.x) + W.o[blk][4 * i + 1] * sc); w.y = pk2(bflo(p.y) + W.o[blk][4 * i + 2] * sc, bfhi(p.y) + W.o[blk][4 * i + 3] * sc);
                *(u32x2*)(orow + 32 * blk + 8 * i + 4 * h) = w; }
    }
}

constexpr int LDS_BIAS = 131072;
__device__ __forceinline__ void unit_compress_full(const Args& a, int id, LAS unsigned char* lds, int tid_in) {
    const int which = id >> 4, b = (id >> 1) & 7, g = id & 1;
    LAS float* bias = (LAS float*)(lds + LDS_BIAS);
    int tid = tid_in; asm volatile("" : "+v"(tid));
    if (tid < 256) bias[tid] = ((const float*)(a.ws + WS_BIASP + 0x10000))[which * 256 + tid];
    __syncthreads();
    bf16_t* CH = (bf16_t*)(a.ws + WS_CH) + (size_t)id * 65536;
    {
        int K = 2048; asm volatile("" : "+s"(K));
        pg8::Gemm gm{(const bf16_t*)(a.ws + WS_BIG), (const bf16_t*)(a.ws + (which ? WS_WCV1 : WS_WCK1)), K, 16 * 64, 128, 2048};
        int one = 1; asm volatile("" : "+s"(one));
        pg8::OneUnit S{(KVN_OFF + ((size_t)(which * 2 + g) * T + (size_t)b * SEQ) * 64) * 2, one};
        pg8::Epi<pg8::EP_STORE> E{CH, 256, nullptr, nullptr, nullptr};
        pg8::gemm_phase<pg8::Epi<pg8::EP_STORE>, pg8::OneUnit, true>(lds, gm, S, E);
    }
    __threadfence();
    __syncthreads();
    tid = tid_in; asm volatile("" : "+v"(tid));
    {
        const int lane = tid & 63, wv = tid >> 6, fr = lane & 15, fq = lane >> 4;
        const bf16_t* w2t = (const bf16_t*)(a.ws + WS_SELM + (which ? 0x8000 : 0));
        f32x4 acc[2][4];
#pragma unroll
        for (int rt = 0; rt < 2; ++rt)
#pragma unroll
            for (int ct = 0; ct < 4; ++ct) acc[rt][ct] = (f32x4){0.f, 0.f, 0.f, 0.f};
        for (int ks = 0; ks < 8; ++ks) {
            const int k0 = 32 * ks + 8 * fq;
            const f32x4 b0 = *(const LAS f32x4*)(bias + k0), b1 = *(const LAS f32x4*)(bias + k0 + 4);
            bf16x8 af[2], bfr[4];
#pragma unroll
            for (int rt = 0; rt < 2; ++rt) {
                const u32x4 hv = *(const u32x4*)(CH + (size_t)(32 * wv + 16 * rt + fr) * 256 + k0);
                float hx[8] = {bflo(hv.x) + b0.x, bfhi(hv.x) + b0.y, bflo(hv.y) + b0.z, bfhi(hv.y) + b0.w, bflo(hv.z) + b1.x, bfhi(hv.z) + b1.y, bflo(hv.w) + b1.z, bfhi(hv.w) + b1.w};
#pragma unroll
                for (int e = 0; e < 8; ++e) { const float x = hx[e]; const float z = 0.7978845608028654f * (x + 0.044715f * x * x * x); hx[e] = x * sigmoidf_(2.0f * z); }
                u32x4 w; w.x = pk2(hx[0], hx[1]); w.y = pk2(hx[2], hx[3]); w.z = pk2(hx[4], hx[5]); w.w = pk2(hx[6], hx[7]);
                af[rt] = __builtin_bit_cast(bf16x8, w);
            }
#pragma unroll
            for (int ct = 0; ct < 4; ++ct) bfr[ct] = *(const bf16x8*)(w2t + (size_t)(16 * ct + fr) * 256 + k0);
#pragma unroll
            for (int rt = 0; rt < 2; ++rt)
#pragma unroll
                for (int ct = 0; ct < 4; ++ct) acc[rt][ct] = __builtin_amdgcn_mfma_f32_16x16x32_bf16(bfr[ct], af[rt], acc[rt][ct], 0, 0, 0);
        }
        bf16_t* obase = (bf16_t*)(a.ws + (which ? WS_VC : WS_KC)) + (size_t)(b * 2 + g) * 256 * 64;
#pragma unroll
        for (int rt = 0; rt < 2; ++rt) { const int c = 32 * wv + 16 * rt + fr;
            if (c < NCMP) {
#pragma unroll
                for (int ct = 0; ct < 4; ++ct) { u32x2 w; w.x = pk2(acc[rt][ct][0], acc[rt][ct][1]); w.y = pk2(acc[rt][ct][2], acc[rt][ct][3]); *(u32x2*)(obase + (size_t)c * 64 + 16 * ct + 4 * fq) = w; }
            } }
    }
    __syncthreads();
}

__device__ __forceinline__ void dil_combine(const Args& a, int gtid, int ngt) {
    const bf16_t* odg = (const bf16_t*)(a.ws + WS_Y); const float* lse = (const float*)(a.ws + WS_LSE); bf16_t* od = (bf16_t*)(a.ws + WS_ODIL);
    for (size_t it = gtid; it < (size_t)T * 32; it += ngt) {
        const size_t tok = it >> 5; const int c8 = (int)(it & 31), hi = c8 >> 3;
        const float l0 = lse[tok * 4 + hi], l1 = lse[((size_t)T + tok) * 4 + hi], l2 = lse[((size_t)2 * T + tok) * 4 + hi];
        const float mx = fmaxf(l0, fmaxf(l1, l2));
        float w0 = __expf(l0 - mx), w1 = __expf(l1 - mx), w2 = __expf(l2 - mx); const float inv = 1.0f / (w0 + w1 + w2); w0 *= inv; w1 *= inv; w2 *= inv;
        const u32x4 p0 = *(const u32x4*)(odg + tok * 256 + c8 * 8), p1 = *(const u32x4*)(odg + ((size_t)T + tok) * 256 + c8 * 8), p2 = *(const u32x4*)(odg + ((size_t)2 * T + tok) * 256 + c8 * 8);
        u32x4 o;
        o.x = pk2(w0 * bflo(p0.x) + w1 * bflo(p1.x) + w2 * bflo(p2.x), w0 * bfhi(p0.x) + w1 * bfhi(p1.x) + w2 * bfhi(p2.x));
        o.y = pk2(w0 * bflo(p0.y) + w1 * bflo(p1.y) + w2 * bflo(p2.y), w0 * bfhi(p0.y) + w1 * bfhi(p1.y) + w2 * bfhi(p2.y));
        o.z = pk2(w0 * bflo(p0.z) + w1 * bflo(p1.z) + w2 * bflo(p2.z), w0 * bfhi(p0.z) + w1 * bfhi(p1.z) + w2 * bfhi(p2.z));
        o.w = pk2(w0 * bflo(p0.w) + w1 * bflo(p1.w) + w2 * bflo(p2.w), w0 * bfhi(p0.w) + w1 * bfhi(p1.w) + w2 * bfhi(p2.w));
        *(u32x4*)(od + tok * 256 + c8 * 8) = o;
    }
}


#define XB_TMO      128
#define XB_XCNT(j)  (256  + 64 * (j))
#define XB_XSUB(j)  (1280 + 64 * (j))
#define XB_XGEN(j)  (2304 + 64 * (j))
#define XB_TOP      3328
#define XB_TOPGEN   3392
#define XCD_BAR_WORDS 3456
#define XB_SPIN_CAP (1u << 18)
__device__ __forceinline__ unsigned xb_ld(unsigned* p)              { return __hip_atomic_load(p, __ATOMIC_RELAXED, __HIP_MEMORY_SCOPE_AGENT); }
__device__ __forceinline__ unsigned xb_add(unsigned* p, unsigned v) { return __hip_atomic_fetch_add(p, v, __ATOMIC_RELAXED, __HIP_MEMORY_SCOPE_AGENT); }
__device__ __forceinline__ unsigned xb_xcc_id() { return (unsigned)__builtin_amdgcn_s_getreg((3 << 11) | 20) & 0xFu; }
#define XB_SPIN(cond, bar) do { unsigned _sp = 0; while (cond) { __builtin_amdgcn_s_sleep(1); \
    if ((++_sp & 255u) == 0u) { if (xb_ld(&(bar)[XB_TMO])) break; if (_sp > XB_SPIN_CAP) { atomicAdd(&(bar)[XB_TMO], 1u); break; } } } } while (0)
struct XcdBarrier { unsigned* bar; unsigned x; volatile LAS unsigned* st; };
__device__ __forceinline__ XcdBarrier xcd_barrier_post(unsigned* bar, volatile LAS unsigned* st) {
    XcdBarrier b; b.bar = bar; b.x = xb_xcc_id(); b.st = st;
    if (threadIdx.x == 0) (void)xb_add(&bar[XB_XCNT(b.x)], 1u);
    return b;
}
__device__ __forceinline__ void xcd_barrier_complete(unsigned* bar, unsigned x, unsigned& nloc, unsigned& nx) {
    const unsigned G = gridDim.x * gridDim.y * gridDim.z;
    unsigned sum, cnt, mine, sp = 0u;
    for (;;) {
        sum = 0u; cnt = 0u; mine = 0u;
#pragma unroll
        for (unsigned j = 0; j < 16; ++j) { const unsigned c = xb_ld(&bar[XB_XCNT(j)]); sum += c; cnt += (c > 0u) ? 1u : 0u; mine = (j == x) ? c : mine; }
        if (sum == G) break;
        __builtin_amdgcn_s_sleep(1);
        if ((++sp & 255u) == 0u) { if (xb_ld(&bar[XB_TMO])) break; if (sp > XB_SPIN_CAP) { atomicAdd(&bar[XB_TMO], 1u); break; } }
    }
    nloc = mine > 0u ? mine : 1u; nx = cnt > 0u ? cnt : 1u;
}
__device__ __forceinline__ void xcd_barrier(const XcdBarrier& b) {
    asm volatile("s_waitcnt vmcnt(0)" ::: "memory");
    __syncthreads();
    if (threadIdx.x == 0) {
        unsigned* bar = b.bar;
        __builtin_amdgcn_s_waitcnt(0);
        unsigned nloc = b.st[0], nx = b.st[1];
        if (nloc == 0u) { xcd_barrier_complete(bar, b.x, nloc, nx); b.st[0] = nloc; b.st[1] = nx; }
        const unsigned old = xb_add(&bar[XB_XSUB(b.x)], 1u);
        const unsigned gen = old / nloc;
        if (old + 1u == (gen + 1u) * nloc) {
            __builtin_amdgcn_fence(__ATOMIC_RELEASE, "agent");
            asm volatile("s_waitcnt vmcnt(0)" ::: "memory");
            const unsigned og = xb_add(&bar[XB_TOP], 1u);
            const unsigned tg = og / nx;
            if (og + 1u == (tg + 1u) * nx) xb_add(&bar[XB_TOPGEN], 1u);
            else XB_SPIN(xb_ld(&bar[XB_TOPGEN]) == tg, bar);
            __builtin_amdgcn_fence(__ATOMIC_ACQUIRE, "agent");
            xb_add(&bar[XB_XGEN(b.x)], 1u);
            asm volatile("s_waitcnt vmcnt(0)" ::: "memory");
        } else {
            XB_SPIN(xb_ld(&bar[XB_XGEN(b.x)]) == gen, bar);
            __builtin_amdgcn_fence(__ATOMIC_ACQUIRE, "agent");
            asm volatile("s_waitcnt vmcnt(0)" ::: "memory");
        }
    }
    __syncthreads();
}

constexpr int NPHASE = 13;
constexpr int LDS_BYTES = 147456;
template <int MODE>
__device__ __forceinline__ void run_gemm(LAS unsigned char* lds, const bf16_t* A, const bf16_t* Bt, int N, int K, bf16_t* O, int ldc, const bf16_t* P1, const bf16_t* P2) {
    asm volatile("" : "+s"(K));
    pg8::Gemm g{A, Bt, K, K, pg8::BK * 2, K};
    pg8::StaticOrder S; S.init(T, N, (int)gridDim.x, (int)blockIdx.x, K);
    pg8::Epi<MODE> E{O, ldc, P1, P2, nullptr};
    pg8::gemm_phase<pg8::Epi<MODE>, pg8::StaticOrder, true>(lds, g, S, E);
}

__global__ void __launch_bounds__(512, 2) mk_fwd(Args a) {
    extern __shared__ __attribute__((aligned(16))) unsigned char lds_raw[];
    LAS unsigned char* lds = (LAS unsigned char*)lds_raw;
    const int G = gridDim.x, bid = blockIdx.x;
#define IDS() int tid = threadIdx.x; asm volatile("" : "+v"(tid)); const int lane = tid & 63, wid = __builtin_amdgcn_readfirstlane(tid >> 6); const int gw = bid * 8 + wid, ngw = G * 8; (void)gw; (void)ngw; (void)lane

    unsigned char* ws = a.ws;
    bf16_t* H = (bf16_t*)(ws + WS_H); bf16_t* Y = (bf16_t*)(ws + WS_Y); bf16_t* BIG = (bf16_t*)(ws + WS_BIG);
    cg::grid_group grid = cg::this_grid();
    if (a.ph_lo < 0) grid.sync();
    volatile LAS unsigned* MISCW = (volatile LAS unsigned*)(lds + LDS_BYTES - 64);
    if (threadIdx.x < 4) MISCW[threadIdx.x] = 0u;
    __syncthreads();
    XcdBarrier bar; bar.bar = (unsigned*)ws; bar.x = 0; bar.st = MISCW;
    if (a.ph_hi - a.ph_lo > 1) bar = xcd_barrier_post((unsigned*)ws, MISCW);
#ifndef PHASE_MASK
#define PHASE_MASK 0xFFFFF
#endif
#define IN(k) ((((PHASE_MASK) >> (k)) & 1) && a.ph_lo <= (k) && (k) < a.ph_hi)
#ifndef REPEAT_MASK
#define REPEAT_MASK 0
#endif
#define REP(k) for (int rep_ = 0; rep_ < ((((REPEAT_MASK) >> (k)) & 1) ? 2 : 1); ++rep_)
#define SEAM(k) do { if (IN(k) && IN((k) + 1)) xcd_barrier(bar); } while (0)

    if (IN(0)) REP(0) {
        IDS();
        int base = 0;
        for (int m = 0; m < W_NMAT; ++m) {
            const MatDesc md = mat_desc(m); const int nit = (md.K / 64) * (md.Nd / 64);
            int first = (gw - base % ngw + ngw) % ngw;
            for (int it = first; it < nit; it += ngw) transpose_item(a, m, it, lane);
            base += nit;
        }
        for (int t = gw; t < 64; t += ngw) {
            const int which = t >> 5, ch = t & 31; const float* pe = a.in[which ? 12 : 9]; const float* w1 = a.in[which ? 13 : 10];
            float s[4] = {0.f, 0.f, 0.f, 0.f};
            for (int k = 64 * ch; k < 64 * ch + 64; ++k) { const float p = pe[k];
#pragma unroll
                for (int j = 0; j < 4; ++j) s[j] += p * w1[(size_t)k * 256 + lane + 64 * j]; }
#pragma unroll
            for (int j = 0; j < 4; ++j) ((float*)(ws + WS_BIASP))[(size_t)t * 256 + lane + 64 * j] = s[j];
        }
        row_pass<false, false>(a.in[0], nullptr, 0.f, nullptr, nullptr, a.in[1], H, gw, ngw, lane);
    }
    SEAM(0);
#ifndef EXTRA_SYNC
#define EXTRA_SYNC 0
#endif
    for (int es_ = 0; es_ < EXTRA_SYNC; ++es_) xcd_barrier(bar);
    if (IN(1)) REP(1) run_gemm<pg8::EP_SWIGLU>(lds, H, (const bf16_t*)(ws + WS_WGU1), NGU, D, BIG, FF, nullptr, nullptr);
    SEAM(1);
    if (IN(2)) REP(2) run_gemm<pg8::EP_STORE>(lds, BIG, (const bf16_t*)(ws + WS_WD1), D, FF, Y, D, nullptr, nullptr);
    SEAM(2);
    if (IN(3)) REP(3) { IDS(); row_pass<false, true>(a.in[0], Y, 0.5f, a.in[2], a.out, a.in[6], H, gw, ngw, lane);
        if (bid == 0) { const float* bp = (const float*)(ws + WS_BIASP) + (size_t)(tid >> 8) * 32 * 256 + (tid & 255); float sbias = 0.f;
            for (int c = 0; c < 32; ++c) sbias += bp[c * 256];
            ((float*)(ws + WS_BIASP + 0x10000))[tid] = sbias; } }
    SEAM(3);
    if (IN(4)) REP(4) run_gemm<pg8::EP_PROJ>(lds, H, (const bf16_t*)(ws + WS_WIN), PITCH, D, BIG, PITCH, nullptr, nullptr);
    SEAM(4);
    if (IN(5)) REP(5) {
        { int tid0 = threadIdx.x; asm volatile("" : "+v"(tid0)); for (int u = bid; u < 32; u += G) unit_compress_full(a, u, lds, tid0); }
        IDS();
        int first, nmine, stride = 1;
        if (G == 256) {
            if (bid < 32) { first = 0; nmine = 0; }
            else { const int w = bid - 32; if (w < 192) { first = 7 * w; nmine = 7; } else { first = 1344 + 6 * (w - 192); nmine = 6; } }
        } else { first = bid; stride = G; nmine = bid < 1536 ? (1536 - bid + G - 1) / G : 0; }
        for (int k = 0; k < nmine; ++k) unit_dilated(a, first + k * stride, lds, tid, wid, lane);
    }
    SEAM(5);
    if (IN(6)) REP(6) {
        IDS();
        if (G == 256) {
            const int x = bid & 7, j = bid >> 3;
            for (int k = 0; k < 4; ++k) { const int p = x + 8 * (k >> 1); unit_nsa(a, p >> 1, p & 1, (k & 1) ? 63 - j : j, lds, tid, wid, lane); }
        } else { for (int u = bid; u < 1024; u += G) { int b, g, qb; gqa_decode(u, b, g, qb); unit_nsa(a, b, g, qb, lds, tid, wid, lane); } }
        dil_combine(a, bid * 512 + tid, G * 512);
    }
    SEAM(6);
    if (IN(7)) REP(7) {
        run_gemm<pg8::EP_SIG>(lds, H, (const bf16_t*)(ws + WS_WGA), D, D, Y, D, nullptr, nullptr);
        run_gemm<pg8::EP_MUL>(lds, (const bf16_t*)(ws + WS_ONSA), (const bf16_t*)(ws + WS_WN), D, 512, Y, D, Y, nullptr);
        run_gemm<pg8::EP_SIG>(lds, H, (const bf16_t*)(ws + WS_WGB), D, D, BIG, D, nullptr, nullptr);
        run_gemm<pg8::EP_FINAL>(lds, (const bf16_t*)(ws + WS_ODIL), (const bf16_t*)(ws + WS_WDIL), D, 256, Y, D, Y, BIG);
    }
    SEAM(7);
    if (IN(8)) REP(8) run_gemm<pg8::EP_STORE>(lds, Y, (const bf16_t*)(ws + WS_WMIX), D, D, BIG + (size_t)32 * MiB, D, nullptr, nullptr);
    SEAM(8);
    if (IN(9)) REP(9) { IDS(); row_pass<true, true>(a.out, BIG + (size_t)32 * MiB, 1.0f, a.in[7], ws + WS_ONSA, a.in[18], H, gw, ngw, lane); }
    SEAM(9);
    if (IN(10)) REP(10) run_gemm<pg8::EP_SWIGLU>(lds, H, (const bf16_t*)(ws + WS_WGU2), NGU, D, BIG, FF, nullptr, nullptr);
    SEAM(10);
    if (IN(11)) REP(11) run_gemm<pg8::EP_STORE>(lds, BIG, (const bf16_t*)(ws + WS_WD2), D, FF, Y, D, nullptr, nullptr);
    SEAM(11);
    if (IN(12)) REP(12) { IDS(); row_pass<true, false>(ws + WS_ONSA, Y, 0.5f, a.in[19], a.out, nullptr, nullptr, gw, ngw, lane); }
#undef IN
#undef SEAM
}

#ifndef MK_ONE_LAUNCH
#define MK_ONE_LAUNCH 1
#endif
extern "C" void kernel_launch(void* const* d_in, const int* in_sizes, int n_in, void* d_out, int out_size, void* d_ws, size_t ws_size, hipStream_t stream) {
    static int grid = 0;
    if (grid == 0) {
        if (n_in != 23 || ws_size < WS_END) { fprintf(stderr, "kernel_launch: unexpected n_in %d / ws_size %zu\n", n_in, ws_size); grid = -1; return; }
        int dev = 0, cus = 0, per_cu = 0;
        hipGetDevice(&dev); hipDeviceGetAttribute(&cus, hipDeviceAttributeMultiprocessorCount, dev);
        hipFuncSetAttribute((const void*)mk_fwd, hipFuncAttributeMaxDynamicSharedMemorySize, LDS_BYTES);
        hipOccupancyMaxActiveBlocksPerMultiprocessor(&per_cu, (const void*)mk_fwd, 512, LDS_BYTES);
        if (per_cu < 1) { fprintf(stderr, "kernel_launch: occupancy query returned %d\n", per_cu); per_cu = 1; }
        (void)hipGetLastError();
        grid = cus * 1;
    }
    if (grid < 0) return;
    if (hipMemsetAsync(d_ws, 0, 16384, stream) != hipSuccess) fprintf(stderr, "kernel_launch: memset failed\n");
    Args a{};
    for (int i = 0; i < 23; ++i) a.in[i] = (const float*)d_in[i];
    a.out = (float*)d_out; a.ws = (unsigned char*)d_ws;
#if MK_ONE_LAUNCH
    a.ph_lo = 0; a.ph_hi = NPHASE;
    void* args[] = {&a};
    hipError_t e = hipLaunchCooperativeKernel((const void*)mk_fwd, dim3(grid), dim3(512), args, LDS_BYTES, stream);
    if (e != hipSuccess) fprintf(stderr, "cooperative launch failed: %s (grid %d)\n", hipGetErrorString(e), grid);
#else
    for (int p = 0; p < NPHASE; ++p) { a.ph_lo = p; a.ph_hi = p + 1; hipLaunchKernelGGL(mk_fwd, dim3(grid), dim3(512), LDS_BYTES, stream, a); }
#endif
}
```

```cpp
#include <hip/hip_runtime.h>
#include <hip/hip_cooperative_groups.h>
#include <cstdio>
#include <cstdint>
namespace cg = cooperative_groups;

#define LAS __attribute__((address_space(3)))
typedef unsigned short bf16_t;
typedef short bf16x8 __attribute__((ext_vector_type(8)));
typedef short s16x4 __attribute__((ext_vector_type(4)));
typedef float f32x2 __attribute__((ext_vector_type(2)));
typedef float f32x4 __attribute__((ext_vector_type(4)));
typedef float f32x16 __attribute__((ext_vector_type(16)));
typedef unsigned u32x2 __attribute__((ext_vector_type(2)));
typedef unsigned u32x4 __attribute__((ext_vector_type(4)));

constexpr int BATCH = 8, SEQ = 4096, T = BATCH * SEQ, D = 1024, FF = 2816, NGU = 2 * FF;
constexpr int IN_DIM = 5656;
constexpr int PITCH = 3840;
constexpr int C_QN = 0, C_KV = 512, C_DIL = 1280, C_GN = 3584;
constexpr int NCMP = 255;
constexpr int QGP = 576;
constexpr size_t KVN_OFF = (size_t)T * QGP, DILS_OFF = KVN_OFF + (size_t)12 * T * 64;
constexpr float LOG2E = 1.4426950408889634f;
constexpr float RMS_EPS = 1e-6f;

constexpr size_t MiB = 1u << 20;
constexpr size_t WS_WGU1 = 2 * MiB, WS_WD1 = 13 * MiB, WS_WGU2 = 19 * MiB, WS_WD2 = 30 * MiB, WS_WIN = 36 * MiB;
constexpr size_t WS_WGA = 44 * MiB, WS_WGB = 46 * MiB, WS_WN = 48 * MiB, WS_WDIL = 49 * MiB, WS_WMIX = 50 * MiB;
constexpr size_t WS_WCK1 = 52 * MiB, WS_WCV1 = 53 * MiB;
constexpr size_t WS_BIASP = 54 * MiB, WS_KC = 54 * MiB + 0x20000, WS_VC = 54 * MiB + 0xA0000, WS_SELM = 54 * MiB + 0x120000;
constexpr size_t WS_CH = 56 * MiB, WS_H = 60 * MiB, WS_Y = 124 * MiB, WS_BIG = 188 * MiB, WS_ONSA = 428 * MiB, WS_ODIL = 460 * MiB;
constexpr size_t WS_END = 476 * MiB;
constexpr size_t WS_LSE = WS_Y + 48 * MiB;

__device__ __forceinline__ unsigned f2bf(float f) { unsigned u = __builtin_bit_cast(unsigned, f); return (u + 0x7fffu + ((u >> 16) & 1u)) >> 16; }
typedef __bf16 bf16x2_t __attribute__((ext_vector_type(2)));
__device__ __forceinline__ unsigned pk2(float lo, float hi) { f32x2 v = {lo, hi}; return __builtin_bit_cast(unsigned, __builtin_convertvector(v, bf16x2_t)); }
__device__ __forceinline__ float bflo(unsigned w) { return __builtin_bit_cast(float, w << 16); }
__device__ __forceinline__ float bfhi(unsigned w) { return __builtin_bit_cast(float, w & 0xffff0000u); }
__device__ __forceinline__ float sigmoidf_(float x) { return __builtin_amdgcn_rcpf(1.0f + __builtin_amdgcn_exp2f(-1.4426950408889634f * x)); }
__device__ __forceinline__ float wave_sum(float v) {
#pragma unroll
    for (int o = 1; o < 64; o <<= 1) v += __shfl_xor(v, o);
    return v;
}

namespace pg8 {
constexpr int BM = 256, BK = 64, HALF = 128, HTB = HALF * BK * 2, STAGE_BYTES = 8 * HTB, NXCD = 8, WGM = 8;
__host__ __device__ __forceinline__ int lds_byte(int r, int c) { const int st = (r >> 4) * 2 + (c >> 5), rr = r & 15, cc = c & 31, ob = rr * 64 + cc * 2; return st * 1024 + (ob ^ (((ob >> 9) & 1) << 5)); }
__host__ __device__ __forceinline__ void stage_rc(int b, int& R, int& C) { const int st = b / 1024, sb = b % 1024, swz = sb ^ (((sb >> 9) & 1) << 5); R = (st >> 1) * 16 + swz / 64; C = (st & 1) * 32 + (swz % 64) / 2; }
__host__ __device__ __forceinline__ int perm32(int rho) { const int n = rho >> 4, i = rho & 15; return 8 * (i >> 2) + 4 * n + (i & 3); }

struct Unit { int pm, pn; };
struct Gemm { const bf16_t* A; const bf16_t* Bt; int K; int lda; int kstepA; int ldb; };

struct StaticOrder {
    int nM, nN, nwg, G, c; size_t tstepA;
    __device__ void init(int M, int N, int G_, int c_, int lda) { nM = M / BM; nN = N / BM; nwg = nM * nN; G = G_; c = c_; tstepA = (size_t)BM * lda * 2; }
    __device__ bool next(int i, Unit& u) const {
        const long L = (long)i * G + c; if (L >= nwg) return false;
        int wgid = (int)L; { const int q = nwg / NXCD, r = nwg % NXCD, xcd = wgid % NXCD, off = wgid / NXCD; wgid = (xcd < r ? xcd * (q + 1) : r * (q + 1) + (xcd - r) * q) + off; }
        const int nig = WGM * nN, gid = wgid / nig, fm = gid * WGM, gsz = (nM - fm) < WGM ? (nM - fm) : WGM;
        u.pm = fm + ((wgid % nig) % gsz); u.pn = (wgid % nig) / gsz; return true;
    }
    __device__ __forceinline__ size_t aoff(const Unit& u) const { return (size_t)u.pm * tstepA; }
};
struct OneUnit {
    size_t off; int n;
    __device__ bool next(int i, Unit& u) const { if (i >= n) return false; u.pm = 0; u.pn = 0; return true; }
    __device__ __forceinline__ size_t aoff(const Unit&) const { return off; }
};

enum { EP_STORE = 0, EP_SIG = 1, EP_MUL = 2, EP_FINAL = 3, EP_SWIGLU = 4, EP_GELU = 5, EP_PROJ = 6 };
template <int MODE> struct Epi {
    static constexpr bool PERM = true;
    bf16_t* O; int ldc; const bf16_t* P1; const bf16_t* P2; const LAS float* bias;
    __device__ __forceinline__ void operator()(const f32x4 (&acc)[2][2][4][2], const Unit& u, int wr, int wc, int fr, int fq) const {
        const int row0 = u.pm * BM + wr * 64 + fr; const int col0 = u.pn * BM + wc * 32 + 8 * fq;
#pragma unroll
        for (int ai = 0; ai < 2; ++ai)
#pragma unroll
            for (int m = 0; m < 4; ++m) {
                const size_t rbase = (size_t)(row0 + ai * HALF + m * 16);
#pragma unroll
                for (int bj = 0; bj < 2; ++bj) {
                    f32x4 v0 = acc[ai][bj][m][0], v1 = acc[ai][bj][m][1];
                    const int col = col0 + bj * HALF;
                    if (MODE == EP_SWIGLU) {
                        u32x2 w; float r[4];
#pragma unroll
                        for (int e = 0; e < 4; ++e) { const float g = v0[e]; r[e] = g * sigmoidf_(g) * v1[e]; }
                        w.x = pk2(r[0], r[1]); w.y = pk2(r[2], r[3]);
                        *(u32x2*)(O + rbase * ldc + (col >> 1)) = w;
                    } else {
                        float r[8] = {v0[0], v0[1], v0[2], v0[3], v1[0], v1[1], v1[2], v1[3]};
                        size_t off = rbase * ldc + col;
                        if (MODE == EP_PROJ) {
                            const int row = (int)rbase;
                            if (u.pn < 2) off = rbase * QGP + col;
                            else if (u.pn < 5) off = KVN_OFF + ((size_t)((col - 512) >> 6) * T + row) * 64 + (col & 63);
                            else if (u.pn < 14) { const int c2 = col - 1280, slab = c2 >> 6, hd = slab % 12, sh = (hd >> 2) * 2  ;
                                const int sq = row & (SEQ - 1), sp = ((sq & ((1 << sh) - 1)) << (12 - sh)) + (sq >> sh);
                                off = DILS_OFF + ((size_t)slab * T + (row & ~(SEQ - 1)) + sp) * 64 + (col & 63); }
                            else { if (col - 3584 >= 64) continue; off = rbase * QGP + 512 + (col - 3584); }
                        }
                        if (MODE == EP_SIG) {
#pragma unroll
                            for (int e = 0; e < 8; ++e) r[e] = sigmoidf_(r[e]);
                        } else if (MODE == EP_MUL) {
                            const u32x4 p = *(const u32x4*)(P1 + off);
                            r[0] *= bflo(p.x); r[1] *= bfhi(p.x); r[2] *= bflo(p.y); r[3] *= bfhi(p.y); r[4] *= bflo(p.z); r[5] *= bfhi(p.z); r[6] *= bflo(p.w); r[7] *= bfhi(p.w);
                        } else if (MODE == EP_FINAL) {
                            const u32x4 p = *(const u32x4*)(P1 + off); const u32x4 q = *(const u32x4*)(P2 + off);
                            r[0] = bflo(p.x) + bflo(q.x) * r[0]; r[1] = bfhi(p.x) + bfhi(q.x) * r[1]; r[2] = bflo(p.y) + bflo(q.y) * r[2]; r[3] = bfhi(p.y) + bfhi(q.y) * r[3];
                            r[4] = bflo(p.z) + bflo(q.z) * r[4]; r[5] = bfhi(p.z) + bfhi(q.z) * r[5]; r[6] = bflo(p.w) + bflo(q.w) * r[6]; r[7] = bfhi(p.w) + bfhi(q.w) * r[7];
                        } else if (MODE == EP_GELU) {
#pragma unroll
                            for (int e = 0; e < 8; ++e) { const float x = r[e] + bias[col + e]; const float z = 0.7978845608028654f * (x + 0.044715f * x * x * x); r[e] = x * sigmoidf_(2.0f * z); }
                        }
                        u32x4 w; w.x = pk2(r[0], r[1]); w.y = pk2(r[2], r[3]); w.z = pk2(r[4], r[5]); w.w = pk2(r[6], r[7]);
                        *(u32x4*)(O + off) = w;
                    }
                    asm volatile("" ::: "memory");
                }
            }
    }
};

template <class EpiT, class Sched, bool ALIGN_EPI>
__device__ __forceinline__ void gemm_phase(LAS unsigned char* lds, const Gemm g, const Sched& S, const EpiT& E) {
    int tid_ = threadIdx.x; asm volatile("" : "+v"(tid_));
    const int tid = tid_, wid = __builtin_amdgcn_readfirstlane(tid >> 6), lane = tid & 63, wr = wid >> 2, wc = wid & 3, fr = lane & 15, fq = lane >> 4;
    const int K = g.K, nt = K / BK;
    unsigned voffA[2], voffB[2];
#pragma unroll
    for (int i = 0; i < 2; ++i) { int R, C; stage_rc(tid * 16 + i * 8192, R, C); const int Rb = EpiT::PERM ? ((R & ~31) + perm32(R & 31)) : R;
        voffA[i] = (unsigned)(R * g.lda + C) * 2u; voffB[i] = (unsigned)(Rb * g.ldb + C) * 2u; }
    const size_t kstepA = (size_t)g.kstepA, kstepB = (size_t)(BK * 2);
    const size_t hstepA = (size_t)HALF * g.lda * 2, hstepB = (size_t)HALF * g.ldb * 2, tstepB = 2 * hstepB;
    const unsigned ldsw = (unsigned)wid * 1024u;
    const int aoff = lds_byte(wr * 64 + fr, fq * 8), boff = lds_byte(wc * 32 + fr, fq * 8);
#define PG8_SA(b, h) (((b) * 2 + (h)) * HTB)
#define PG8_SB(b, h) ((4 + (b) * 2 + (h)) * HTB)
#define PG8_STAGE(bufoff, gbase, voff) do { _Pragma("unroll") for (int _i = 0; _i < 2; ++_i) \
        __builtin_amdgcn_global_load_lds((const unsigned*)((const char*)(gbase) + (voff)[_i]), (LAS unsigned*)(lds + (bufoff) + ldsw + _i * 8192), 16, 0, 0); } while (0)
#define PG8_LDA(dst, b, h) do { _Pragma("unroll") for (int m = 0; m < 4; ++m) _Pragma("unroll") for (int k = 0; k < 2; ++k) dst[m][k] = *(const LAS bf16x8*)(lds + PG8_SA(b, h) + aoff + m * 2048 + k * 1024); } while (0)
#define PG8_LDB(dst, b, h) do { _Pragma("unroll") for (int n = 0; n < 2; ++n) _Pragma("unroll") for (int k = 0; k < 2; ++k) dst[n][k] = *(const LAS bf16x8*)(lds + PG8_SB(b, h) + boff + n * 2048 + k * 1024); } while (0)
#define PG8_MMA(ai, bj, At, Bt) do { __builtin_amdgcn_s_setprio(1); _Pragma("unroll") for (int m = 0; m < 4; ++m) _Pragma("unroll") for (int n = 0; n < 2; ++n) _Pragma("unroll") for (int k = 0; k < 2; ++k) \
        acc[ai][bj][m][n] = __builtin_amdgcn_mfma_f32_16x16x32_bf16(Bt[n][k], At[m][k], acc[ai][bj][m][n], 0, 0, 0); __builtin_amdgcn_s_setprio(0); } while (0)
#define PG8_WAIT_V(n) asm volatile("s_waitcnt vmcnt(" #n ")" ::: "memory")
#define PG8_WAIT_L(n) asm volatile("s_waitcnt lgkmcnt(" #n ")" ::: "memory")
#define PG8_BAR __builtin_amdgcn_s_barrier()
#define PG8_SCHED __builtin_amdgcn_sched_barrier(0)
    Unit cur, nxt; int ui = 0;
    if (!S.next(0, cur)) return;
    f32x4 acc[2][2][4][2];
#pragma unroll
    for (int a = 0; a < 2; ++a)
#pragma unroll
        for (int b = 0; b < 2; ++b)
#pragma unroll
            for (int m = 0; m < 4; ++m)
#pragma unroll
                for (int n = 0; n < 2; ++n) acc[a][b][m][n] = (f32x4){0.f, 0.f, 0.f, 0.f};
    bf16x8 At[4][2], B0[2][2], B1[2][2];
    const char* cA = (const char*)g.A + S.aoff(cur); const char* cB = (const char*)g.Bt + (size_t)cur.pn * tstepB;
    PG8_STAGE(PG8_SB(0, 0), cB, voffB); PG8_STAGE(PG8_SB(0, 1), cB + hstepB, voffB); PG8_STAGE(PG8_SA(0, 0), cA, voffA); PG8_STAGE(PG8_SA(0, 1), cA + hstepA, voffA);
    if (wr == 1) PG8_BAR;
    PG8_WAIT_V(2); PG8_BAR;
    PG8_STAGE(PG8_SB(1, 0), cB + kstepB, voffB); PG8_STAGE(PG8_SA(1, 0), cA + kstepA, voffA); PG8_STAGE(PG8_SB(1, 1), cB + hstepB + kstepB, voffB);
    PG8_WAIT_V(6); PG8_BAR;
    for (;;) {
        const bool has_next = S.next(ui + 1, nxt);
        const char* nA = has_next ? (const char*)g.A + S.aoff(nxt) : cA; const char* nB = has_next ? (const char*)g.Bt + (size_t)nxt.pn * tstepB : cB;
        for (int t = 0; t < nt; t += 2) {
            const bool last = (t == nt - 2);
            const char* a1 = cA + (size_t)(t + 1) * kstepA;
            const char* a2 = last ? nA : cA + (size_t)(t + 2) * kstepA; const char* b2 = last ? nB : cB + (size_t)(t + 2) * kstepB;
            const char* a3 = a2 + kstepA; const char* b3 = b2 + kstepB;
            PG8_LDB(B0, 0, 0); PG8_LDB(B1, 0, 1); PG8_SCHED; PG8_LDA(At, 0, 0); PG8_STAGE(PG8_SA(1, 1), a1 + hstepA, voffA);
            PG8_WAIT_V(8); PG8_WAIT_L(0); PG8_BAR; PG8_MMA(0, 0, At, B0); PG8_MMA(0, 1, At, B1); PG8_BAR; PG8_SCHED;
            PG8_LDA(At, 0, 1); PG8_STAGE(PG8_SB(0, 0), b2, voffB); PG8_STAGE(PG8_SB(0, 1), b2 + hstepB, voffB); PG8_STAGE(PG8_SA(0, 0), a2, voffA);
            PG8_WAIT_V(8); PG8_WAIT_L(0); PG8_BAR; PG8_MMA(1, 0, At, B0); PG8_MMA(1, 1, At, B1); PG8_BAR; PG8_SCHED;
            PG8_LDB(B0, 1, 0); PG8_LDB(B1, 1, 1); PG8_SCHED; PG8_LDA(At, 1, 0); PG8_STAGE(PG8_SA(0, 1), a2 + hstepA, voffA);
            PG8_WAIT_V(8); PG8_WAIT_L(0); PG8_BAR; PG8_MMA(0, 0, At, B0); PG8_MMA(0, 1, At, B1); PG8_BAR; PG8_SCHED;
            PG8_LDA(At, 1, 1); PG8_STAGE(PG8_SB(1, 0), b3, voffB); PG8_STAGE(PG8_SB(1, 1), b3 + hstepB, voffB); PG8_STAGE(PG8_SA(1, 0), a3, voffA);
            PG8_WAIT_V(8); PG8_WAIT_L(0); PG8_BAR; PG8_MMA(1, 0, At, B0); PG8_MMA(1, 1, At, B1); PG8_BAR; PG8_SCHED;
        }
        if constexpr (ALIGN_EPI) { if (wr == 0) PG8_BAR; }
        E(acc, cur, wr, wc, fr, fq);
        if (!has_next) break;
#pragma unroll
        for (int a = 0; a < 2; ++a)
#pragma unroll
            for (int b = 0; b < 2; ++b)
#pragma unroll
                for (int m = 0; m < 4; ++m)
#pragma unroll
                    for (int n = 0; n < 2; ++n) acc[a][b][m][n] = (f32x4){0.f, 0.f, 0.f, 0.f};
        cur = nxt; cA = nA; cB = nB; ++ui;
        if constexpr (ALIGN_EPI) { if (wr == 1) PG8_BAR; }
    }
    PG8_WAIT_V(0);
    if constexpr (!ALIGN_EPI) { if (wr == 0) PG8_BAR; }
    PG8_BAR;
#undef PG8_SA
#undef PG8_SB
#undef PG8_STAGE
#undef PG8_LDA
#undef PG8_LDB
#undef PG8_MMA
#undef PG8_WAIT_V
#undef PG8_WAIT_L
#undef PG8_BAR
#undef PG8_SCHED
}
}

struct Args { const float* in[23]; float* out; unsigned char* ws; int ph_lo, ph_hi; };

enum { W_GU1 = 0, W_D1, W_GU2, W_D2, W_IN, W_GA, W_GB, W_N, W_DIL, W_MIX, W_CK1, W_CV1, W_CK2, W_CV2, W_NMAT };
struct MatDesc { int K, Nd; size_t wsoff; };
__device__ __forceinline__ MatDesc mat_desc(int m) {
    switch (m) {
        case W_GU1: return {D, NGU, WS_WGU1};
        case W_D1: return {FF, D, WS_WD1};
        case W_GU2: return {D, NGU, WS_WGU2};
        case W_D2: return {FF, D, WS_WD2};
        case W_IN: return {D, PITCH, WS_WIN};
        case W_GA: return {D, D, WS_WGA};
        case W_GB: return {D, D, WS_WGB};
        case W_N: return {512, D, WS_WN};
        case W_DIL: return {256, D, WS_WDIL};
        case W_MIX: return {D, D, WS_WMIX};
        case W_CK1: return {2048, 256, WS_WCK1};
        case W_CV1: return {2048, 256, WS_WCV1};
        case W_CK2: return {256, 64, WS_SELM};
        default: return {256, 64, WS_SELM + 0x8000};
    }
}
__device__ __forceinline__ const float* mat_src(const Args& a, int m, int n, int& ldw) {
    switch (m) {
        case W_GU1: case W_GU2: { ldw = FF; const int c = (n >> 3) * 4 + (n & 3); const int gi = (m == W_GU1) ? 3 : 20; return ((n & 4) ? a.in[gi + 1] : a.in[gi]) + c; }
        case W_D1: ldw = D; return a.in[5] + n;
        case W_D2: ldw = D; return a.in[22] + n;
        case W_IN: { ldw = IN_DIM; int c; if (n < 1280) c = n; else if (n < 3584) c = n + 24; else if (n < 3608) c = n - 3584 + 1280; else return nullptr; return a.in[8] + c; }
        case W_GA: ldw = IN_DIM; return a.in[8] + 3608 + n;
        case W_GB: ldw = IN_DIM; return a.in[8] + 4632 + n;
        case W_N: ldw = D; return a.in[15] + n;
        case W_DIL: ldw = D; return a.in[16] + n;
        case W_MIX: ldw = D; return a.in[17] + n;
        case W_CK1: ldw = 256; return a.in[10] + n;
        case W_CV1: ldw = 256; return a.in[13] + n;
        case W_CK2: ldw = 64; return a.in[11] + n;
        default: ldw = 64; return a.in[14] + n;
    }
}
__device__ __forceinline__ void transpose_item(const Args& a, int m, int item, int lane) {
    const MatDesc md = mat_desc(m);
    const int nblk = md.Nd / 64, kb = item / nblk, nb = item % nblk, k0 = 64 * kb, n0 = 64 * nb;
    int ldw = 0; const float* src = mat_src(a, m, n0 + lane, ldw);
    float v[64];
    if (src) {
        const float* p = src + (size_t)k0 * ldw;
#pragma unroll
        for (int kk = 0; kk < 64; ++kk) v[kk] = p[(size_t)kk * ldw];
    } else {
#pragma unroll
        for (int kk = 0; kk < 64; ++kk) v[kk] = 0.f;
    }
    u32x4* dst = (u32x4*)((bf16_t*)(a.ws + md.wsoff) + (size_t)(n0 + lane) * md.K + k0);
#pragma unroll
    for (int c = 0; c < 8; ++c) { u32x4 o; o.x = pk2(v[8 * c], v[8 * c + 1]); o.y = pk2(v[8 * c + 2], v[8 * c + 3]); o.z = pk2(v[8 * c + 4], v[8 * c + 5]); o.w = pk2(v[8 * c + 6], v[8 * c + 7]); dst[c] = o; }
}

template <bool XIN16, bool XO16>
__device__ __forceinline__ void row_pass(const void* xin_, const bf16_t* y, float scale, const float* gpost, void* xo_, const float* gnext, bf16_t* hout, int gw, int ngw, int lane) {
    const float* xin = (const float*)xin_; const bf16_t* xin16 = (const bf16_t*)xin_; float* xo = (float*)xo_; bf16_t* xo16 = (bf16_t*)xo_;
    f32x4 nv[4]; u32x2 ny[4];
#pragma unroll
    for (int j = 0; j < 4; ++j) { nv[j] = (f32x4){0.f, 0.f, 0.f, 0.f}; ny[j] = (u32x2){0u, 0u}; }
    if (gw < T) {
        if (XIN16) { const u32x2* xr = (const u32x2*)(xin16 + (size_t)gw * D) + lane;
#pragma unroll
            for (int j = 0; j < 4; ++j) { const u32x2 w = xr[64 * j]; nv[j] = (f32x4){bflo(w.x), bfhi(w.x), bflo(w.y), bfhi(w.y)}; } }
        else { const f32x4* xr = (const f32x4*)(xin + (size_t)gw * D) + lane;
#pragma unroll
            for (int j = 0; j < 4; ++j) nv[j] = xr[64 * j]; }
        if (y) { const u32x2* yr = (const u32x2*)(y + (size_t)gw * D) + lane;
#pragma unroll
            for (int j = 0; j < 4; ++j) ny[j] = yr[64 * j]; }
    }
    for (int m = gw; m < T; m += ngw) {
        f32x4 v[4]; u32x2 yw[4];
#pragma unroll
        for (int j = 0; j < 4; ++j) { v[j] = nv[j]; yw[j] = ny[j]; }
        const int mn = m + ngw;
        if (mn < T) {
            if (XIN16) { const u32x2* xr = (const u32x2*)(xin16 + (size_t)mn * D) + lane;
#pragma unroll
                for (int j = 0; j < 4; ++j) { const u32x2 w = xr[64 * j]; nv[j] = (f32x4){bflo(w.x), bfhi(w.x), bflo(w.y), bfhi(w.y)}; } }
            else { const f32x4* xr = (const f32x4*)(xin + (size_t)mn * D) + lane;
#pragma unroll
                for (int j = 0; j < 4; ++j) nv[j] = xr[64 * j]; }
            if (y) { const u32x2* yr = (const u32x2*)(y + (size_t)mn * D) + lane;
#pragma unroll
                for (int j = 0; j < 4; ++j) ny[j] = yr[64 * j]; }
        }
        if (y) {
            f32x4 yv[4]; float s = 0.f;
#pragma unroll
            for (int j = 0; j < 4; ++j) { const u32x2 w = yw[j]; yv[j] = (f32x4){bflo(w.x), bfhi(w.x), bflo(w.y), bfhi(w.y)}; s += (yv[j].x * yv[j].x + yv[j].y * yv[j].y) + (yv[j].z * yv[j].z + yv[j].w * yv[j].w); }
            const float rs = rsqrtf(wave_sum(s) * (1.f / D) + RMS_EPS) * scale;
#pragma unroll
            for (int j = 0; j < 4; ++j) { const f32x4 g = ((const f32x4*)gpost)[lane + 64 * j]; v[j] = v[j] + yv[j] * rs * g; }
            if (XO16) { u32x2* xw = (u32x2*)(xo16 + (size_t)m * D) + lane;
#pragma unroll
                for (int j = 0; j < 4; ++j) { u32x2 w; w.x = pk2(v[j].x, v[j].y); w.y = pk2(v[j].z, v[j].w); xw[64 * j] = w; } }
            else { f32x4* xw = (f32x4*)(xo + (size_t)m * D) + lane;
#pragma unroll
                for (int j = 0; j < 4; ++j) xw[64 * j] = v[j]; }
        }
        if (hout) {
            float s = 0.f;
#pragma unroll
            for (int j = 0; j < 4; ++j) s += (v[j].x * v[j].x + v[j].y * v[j].y) + (v[j].z * v[j].z + v[j].w * v[j].w);
            const float rs = rsqrtf(wave_sum(s) * (1.f / D) + RMS_EPS);
            u32x2* hw = (u32x2*)(hout + (size_t)m * D) + lane;
#pragma unroll
            for (int j = 0; j < 4; ++j) { const f32x4 g = ((const f32x4*)gnext)[lane + 64 * j]; const f32x4 o = v[j] * rs * g; u32x2 w; w.x = pk2(o.x, o.y); w.y = pk2(o.z, o.w); hw[64 * j] = w; }
        }
    }
}

constexpr int KP = 144, VP = 192;
constexpr int KST = 64 * KP, VST = 64 * VP;
constexpr int ATT_K0 = 0, ATT_V0 = 2 * KST;
constexpr int ATT_MISC = ATT_V0 + 2 * VST;
constexpr int ATT_SELL = ATT_MISC + 128;
constexpr int ATT_IMP = 44032;
constexpr int ATT_ACC = 110592;
enum { AT_BAND = 0, AT_CMP = 1, AT_SEL = 2 };
enum { MD_ONLINE = 0, MD_STATS = 1, MD_NORM = 2 };

__device__ __forceinline__ s16x4 tr16(const LAS unsigned char* p) {
    return __builtin_bit_cast(s16x4, __builtin_amdgcn_ds_read_tr16_b64_v4i16((LAS s16x4*)p));
}
__device__ __forceinline__ float xhalf_max(float m) {
    auto rr = __builtin_amdgcn_permlane32_swap(__builtin_bit_cast(unsigned, m), __builtin_bit_cast(unsigned, m), false, false);
    return fmaxf(__builtin_bit_cast(float, rr[0]), __builtin_bit_cast(float, rr[1]));
}

struct AttnWave {
    bf16x8 qf[4];
    f32x16 o[2];
    float kb[16];
    float m, l;
    int iq, i0w;
    int jlo, jhi;
    float c1, sb;
    int j0;
    int max_back;
    unsigned long long mysel;
    float mfin, invl;
    bool started;
};

template <int TYPE, int MODE>
__device__ __forceinline__ void attn_stage(AttnWave& W, const LAS unsigned char* Kl, const LAS unsigned char* Vl, int cur, int lane, LAS float* imp  , bool wave_skip_sel) {
    const int r32 = lane & 31, h = lane >> 5;
    const int jt = 64 * cur;
    {
        bool skip = (jt + 63 < W.jlo) || (jt > W.jhi);
        if (TYPE == AT_SEL) skip = skip || wave_skip_sel;
        if (TYPE == AT_CMP && MODE == MD_NORM) skip = false;
        if (skip) return;
    }
    bool lane_on = true;
    if (TYPE == AT_SEL) lane_on = ((W.mysel >> cur) & 1ull) != 0ull;
    const float ref = (MODE == MD_NORM) ? W.mfin : W.m;
    float base0 = W.sb * (float)(jt - W.j0) - ref;
    if (TYPE == AT_SEL) base0 = lane_on ? base0 : -INFINITY;
    const float base1 = base0 + 32.0f * W.sb;
    f32x16 s0, s1;
#pragma unroll
    for (int r = 0; r < 16; ++r) { s0[r] = W.kb[r] + base0; s1[r] = W.kb[r] + base1; }
    const LAS unsigned char* kp = Kl + r32 * KP + h * 16;
    bf16x8 kf0[4], kf1[4];
#pragma unroll
    for (int ds = 0; ds < 4; ++ds) { kf0[ds] = *(const LAS bf16x8*)(kp + ds * 32); kf1[ds] = *(const LAS bf16x8*)(kp + 32 * KP + ds * 32); }
    __builtin_amdgcn_sched_barrier(0);
#pragma unroll
    for (int ds = 0; ds < 4; ++ds) {
        s0 = __builtin_amdgcn_mfma_f32_32x32x16_bf16(kf0[ds], W.qf[ds], s0, 0, 0, 0);
        s1 = __builtin_amdgcn_mfma_f32_32x32x16_bf16(kf1[ds], W.qf[ds], s1, 0, 0, 0);
    }
    const LAS unsigned char* vp = Vl + (4 * h + ((lane & 15) >> 2)) * VP + (16 * ((lane >> 4) & 1) + 4 * (lane & 3)) * 2;
    s16x4 vlo[4][2], vhi[4][2];
    if (MODE != MD_STATS) {
#pragma unroll
        for (int s4 = 0; s4 < 4; ++s4)
#pragma unroll
            for (int blk = 0; blk < 2; ++blk) { vlo[s4][blk] = tr16(vp + (16 * s4) * VP + blk * 64); vhi[s4][blk] = tr16(vp + (16 * s4 + 8) * VP + blk * 64); }
    }
    __builtin_amdgcn_sched_barrier(0);
    float x0[16], x1[16];
#pragma unroll
    for (int r = 0; r < 16; ++r) { x0[r] = s0[r]; x1[r] = s1[r]; }
    if (TYPE == AT_BAND) {
        const bool interior = (jt + 63 <= W.i0w) && (W.i0w + 31 - jt <= W.max_back);
        if (!interior) {
            const int d = W.iq - jt - 4 * h;
#pragma unroll
            for (int r = 0; r < 16; ++r) { const int cr = (r & 3) + 8 * (r >> 2);
                x0[r] = ((unsigned)(d - cr) <= (unsigned)W.max_back) ? x0[r] : -INFINITY;
                x1[r] = ((unsigned)(d - 32 - cr) <= (unsigned)W.max_back) ? x1[r] : -INFINITY; }
        }
    } else if (TYPE == AT_CMP) {
        int lim = (W.iq - 31) >> 4; lim = lim > NCMP - 1 ? NCMP - 1 : lim; lim -= jt + 4 * h;
#pragma unroll
        for (int r = 0; r < 16; ++r) { const int cr = (r & 3) + 8 * (r >> 2); x0[r] = (cr <= lim) ? x0[r] : -INFINITY; x1[r] = (cr + 32 <= lim) ? x1[r] : -INFINITY; }
    } else {
        if (jt + 63 > W.i0w) {
            const int d = W.iq - jt - 4 * h;
#pragma unroll
            for (int r = 0; r < 16; ++r) { const int cr = (r & 3) + 8 * (r >> 2); x0[r] = (cr <= d) ? x0[r] : -INFINITY; x1[r] = (cr + 32 <= d) ? x1[r] : -INFINITY; }
        }
    }
    float p0[16], p1[16];
    if (MODE != MD_NORM) {
        float ma = fmaxf(fmaxf(x0[0], x0[1]), fmaxf(x0[2], x0[3])), mb = fmaxf(fmaxf(x1[0], x1[1]), fmaxf(x1[2], x1[3]));
#pragma unroll
        for (int r = 4; r < 16; r += 4) { ma = fmaxf(ma, fmaxf(fmaxf(x0[r], x0[r + 1]), fmaxf(x0[r + 2], x0[r + 3]))); mb = fmaxf(mb, fmaxf(fmaxf(x1[r], x1[r + 1]), fmaxf(x1[r + 2], x1[r + 3]))); }
        const float gmx = xhalf_max(fmaxf(ma, mb));
        const bool need = W.started ? (gmx > 60.0f) : (gmx > -INFINITY);
        if (__builtin_amdgcn_ballot_w64(need) != 0ull) {
            const float delta = need ? gmx : 0.f;
            const float f = W.started ? __builtin_amdgcn_exp2f(-delta) : 1.0f;
            W.m += delta; W.started = W.started || need;
            W.l *= f;
#pragma unroll
            for (int r = 0; r < 16; ++r) { x0[r] -= delta; x1[r] -= delta; }
            if (MODE == MD_ONLINE) {
#pragma unroll
                for (int r = 0; r < 16; ++r) { W.o[0][r] *= f; W.o[1][r] *= f; }
            }
        }
        float lsa = 0.f, lsb = 0.f;
#pragma unroll
        for (int r = 0; r < 16; ++r) { p0[r] = __builtin_amdgcn_exp2f(x0[r]); lsa += p0[r]; p1[r] = __builtin_amdgcn_exp2f(x1[r]); lsb += p1[r]; }
        W.l += lsa + lsb;
    } else {
#pragma unroll
        for (int r = 0; r < 16; ++r) { p0[r] = __builtin_amdgcn_exp2f(x0[r]) * W.invl; p1[r] = __builtin_amdgcn_exp2f(x1[r]) * W.invl; }
    }
    if (TYPE == AT_CMP && MODE == MD_NORM) {
#pragma unroll
        for (int hf = 0; hf < 2; ++hf)
#pragma unroll
            for (int i = 0; i < 4; ++i) {
                const float q0 = hf ? p1[4 * i] : p0[4 * i], q1 = hf ? p1[4 * i + 1] : p0[4 * i + 1], q2 = hf ? p1[4 * i + 2] : p0[4 * i + 2], q3 = hf ? p1[4 * i + 3] : p0[4 * i + 3];
                const float Bv = 0.5f * q3;
                const float A = (q0 + q1) + (q2 + Bv);
                const int u = 8 * (2 * cur + hf) + 2 * i + h;
                imp[u] += A;
                asm volatile("" ::: "memory");
                imp[u + 1] += Bv;
                asm volatile("" ::: "memory");
            }
    }
    if (MODE != MD_STATS) {
        bf16x8 pb[4];
#pragma unroll
        for (int s2 = 0; s2 < 2; ++s2) {
            u32x4 w; w.x = pk2(p0[8 * s2 + 0], p0[8 * s2 + 1]); w.y = pk2(p0[8 * s2 + 2], p0[8 * s2 + 3]); w.z = pk2(p0[8 * s2 + 4], p0[8 * s2 + 5]); w.w = pk2(p0[8 * s2 + 6], p0[8 * s2 + 7]);
            pb[s2] = __builtin_bit_cast(bf16x8, w);
            u32x4 z; z.x = pk2(p1[8 * s2 + 0], p1[8 * s2 + 1]); z.y = pk2(p1[8 * s2 + 2], p1[8 * s2 + 3]); z.z = pk2(p1[8 * s2 + 4], p1[8 * s2 + 5]); z.w = pk2(p1[8 * s2 + 6], p1[8 * s2 + 7]);
            pb[2 + s2] = __builtin_bit_cast(bf16x8, z);
        }
#pragma unroll
        for (int s4 = 0; s4 < 4; ++s4) {
#pragma unroll
            for (int blk = 0; blk < 2; ++blk) {
                const s16x4 lo = vlo[s4][blk], hi = vhi[s4][blk];
                const bf16x8 vf = (bf16x8){lo[0], lo[1], lo[2], lo[3], hi[0], hi[1], hi[2], hi[3]};
                W.o[blk] = __builtin_amdgcn_mfma_f32_32x32x16_bf16(vf, pb[s4], W.o[blk], 0, 0, 0);
            }
        }
    }
}

struct AttnUnitDesc {
    const bf16_t* K; const bf16_t* V; long kvstride; int jclamp;
    unsigned long long stmask;
};

template <int TYPE, int MODE, int NH = 1>
__device__ __forceinline__ void attn_run(AttnWave& W, const AttnUnitDesc& U, LAS unsigned char* lds, int tid, int lane, LAS float* imp, unsigned long long wavemask, int hsel = 0, size_t hstride = 0) {
    const int srow = tid >> 3, sch = tid & 7;
    constexpr int V0 = 2 * NH * KST;
    unsigned long long rem = U.stmask;
    int cur = 63 - __builtin_clzll(rem); rem &= ~(1ull << cur);
    u32x4 kreg[NH], vreg[NH];
    { int j = 64 * cur + srow; j = j > U.jclamp ? U.jclamp : j; const size_t off = (size_t)j * U.kvstride + sch * 8;
#pragma unroll
      for (int hs = 0; hs < NH; ++hs) { kreg[hs] = *(const u32x4*)(U.K + off + hs * hstride); vreg[hs] = *(const u32x4*)(U.V + off + hs * hstride); } }
    int buf = 0;
#pragma unroll
    for (int hs = 0; hs < NH; ++hs) { *(LAS u32x4*)(lds + hs * KST + srow * KP + sch * 16) = kreg[hs]; *(LAS u32x4*)(lds + V0 + hs * VST + srow * VP + sch * 16) = vreg[hs]; }
    __syncthreads();
    for (;;) {
        int nxt = -1;
        if (rem) { nxt = 63 - __builtin_clzll(rem); rem &= ~(1ull << nxt);
            int j = 64 * nxt + srow; j = j > U.jclamp ? U.jclamp : j; const size_t off = (size_t)j * U.kvstride + sch * 8;
#pragma unroll
            for (int hs = 0; hs < NH; ++hs) { kreg[hs] = *(const u32x4*)(U.K + off + hs * hstride); vreg[hs] = *(const u32x4*)(U.V + off + hs * hstride); } }
        const bool wskip = (TYPE == AT_SEL) ? (((wavemask >> cur) & 1ull) == 0ull) : false;
        attn_stage<TYPE, MODE>(W, lds + (buf * NH + hsel) * KST, lds + V0 + (buf * NH + hsel) * VST, cur, lane, imp, wskip);
        if (nxt < 0) break;
#pragma unroll
        for (int hs = 0; hs < NH; ++hs) { *(LAS u32x4*)(lds + ((buf ^ 1) * NH + hs) * KST + srow * KP + sch * 16) = kreg[hs]; *(LAS u32x4*)(lds + V0 + ((buf ^ 1) * NH + hs) * VST + srow * VP + sch * 16) = vreg[hs]; }
        __syncthreads();
        buf ^= 1; cur = nxt;
    }
    __syncthreads();
}

__device__ __forceinline__ void attn_init(AttnWave& W, int lane, int i0w, float slope_l2, int dstep) {
#pragma unroll
    for (int r = 0; r < 16; ++r) { W.o[0][r] = 0.f; W.o[1][r] = 0.f; }
    W.m = 0.f; W.l = 0.f; W.mysel = 0ull; W.mfin = 0.f; W.invl = 0.f; W.max_back = 0; W.started = false;
    W.i0w = i0w; W.iq = i0w + (lane & 31); W.c1 = 0.125f * LOG2E; W.sb = slope_l2 * (float)dstep;
#pragma unroll
    for (int r = 0; r < 16; ++r) W.kb[r] = W.sb * (float)((r & 3) + 8 * (r >> 2) + 4 * (lane >> 5));
}
__device__ __forceinline__ void load_q(AttnWave& W, const bf16_t* Qw, long qstride, int lane) {
    const int r32 = lane & 31, h = lane >> 5;
#pragma unroll
    for (int ds = 0; ds < 4; ++ds) {
        const u32x4 w = *(const u32x4*)(Qw + (size_t)r32 * qstride + 16 * ds + 8 * h); const float c = W.c1;
        u32x4 o; o.x = pk2(bflo(w.x) * c, bfhi(w.x) * c); o.y = pk2(bflo(w.y) * c, bfhi(w.y) * c); o.z = pk2(bflo(w.z) * c, bfhi(w.z) * c); o.w = pk2(bflo(w.w) * c, bfhi(w.w) * c);
        W.qf[ds] = __builtin_bit_cast(bf16x8, o);
    }
}

__device__ __forceinline__ float nsa_slope(int head) { return exp2f(-(float)(head + 1)); }
__device__ __forceinline__ void gqa_decode(int u, int& b, int& g, int& qb) {
    const int low6 = u & 63, hi4 = u >> 6, k = hi4 >> 2; b = hi4 >> 1; g = hi4 & 1;
    const int base = (low6 + 32 * (k >> 1)) & 63; qb = (k & 1) ? 63 - base : base;
}

__device__ __forceinline__ void unit_dilated(const Args& a, int id, LAS unsigned char* lds, int tid, int wid, int lane) {
    const int grp = id >> 9, rem = id & 511, b = rem >> 6, hp = (rem >> 5) & 1, sub = rem & 31;
    const int dil = grp == 0 ? 1 : (grp == 1 ? 4 : 16);
    const int r = sub % dil, ublk = sub / dil;
    const int hsel = wid >> 2, hi = 2 * hp + hsel;
    const bf16_t* slab0 = (const bf16_t*)(a.ws + WS_BIG) + DILS_OFF + ((size_t)(4 * grp + 2 * hp) * T + (size_t)b * SEQ + (size_t)r * (SEQ / dil)) * 64;
    const int i0w = 128 * ublk + 32 * (wid & 3);
    const float slope = exp2f(-8.0f * (float)(4 * grp + hi + 1) / 12.0f);
    AttnWave W; attn_init(W, lane, i0w, slope * LOG2E, dil);
    load_q(W, slab0 + (size_t)hsel * T * 64 + (size_t)i0w * 64, 64, lane);
    W.jlo = i0w - 128; W.jhi = i0w + 31; W.max_back = 128;
    const int slo = ublk > 0 ? 2 * ublk - 2 : 0, shi = 2 * ublk + 1; W.j0 = 64 * shi;
    AttnUnitDesc U; U.K = slab0 + (size_t)12 * T * 64; U.V = slab0 + (size_t)24 * T * 64; U.kvstride = 64; U.jclamp = SEQ / dil - 1;
    U.stmask = ((shi == 63) ? ~0ull : ((2ull << shi) - 1ull)) & ~((1ull << slo) - 1ull);
    attn_run<AT_BAND, MD_ONLINE, 2>(W, U, lds, tid, lane, nullptr, 0ull, hsel, (size_t)T * 64);
    const float lt = W.l + __shfl_xor(W.l, 32); const float inv = 1.0f / fmaxf(lt, 1e-30f);
    const size_t tok = (size_t)b * SEQ + (size_t)dil * W.iq + r;
    bf16_t* orow = (bf16_t*)(a.ws + WS_Y) + ((size_t)grp * T + tok) * 256 + hi * 64;
    const int h = lane >> 5;
#pragma unroll
    for (int blk = 0; blk < 2; ++blk)
#pragma unroll
        for (int i = 0; i < 4; ++i) { u32x2 w; w.x = pk2(W.o[blk][4 * i] * inv, W.o[blk][4 * i + 1] * inv); w.y = pk2(W.o[blk][4 * i + 2] * inv, W.o[blk][4 * i + 3] * inv);
            *(u32x2*)(orow + 32 * blk + 8 * i + 4 * h) = w; }
    if (h == 0) ((float*)(a.ws + WS_LSE))[((size_t)grp * T + tok) * 4 + hi] = (W.m + __log2f(lt) - W.sb * (float)(W.iq - W.j0)) * 0.6931471805599453f;
}

__device__ __forceinline__ void unit_nsa(const Args& a, int b, int g, int qb, LAS unsigned char* lds, int tid, int wid, int lane) {
    const bf16_t* big = (const bf16_t*)(a.ws + WS_BIG);
    const bf16_t* kvn = big + KVN_OFF + (size_t)b * SEQ * 64;
    const int hl = wid >> 1, head = g * 4 + hl, i0w = 64 * qb + 32 * (wid & 1);
    const float sl2 = nsa_slope(head) * LOG2E;
    LAS float* IMP = (LAS float*)(lds + ATT_IMP);
    for (int i = tid; i < 4 * 64 * 65; i += 512) IMP[i] = 0.f;
    const size_t tok = (size_t)b * SEQ + i0w + (lane & 31);
    const bf16_t* gp = big + tok * QGP + 512 + head * 3;
    const float g0 = sigmoidf_(bflo((unsigned)gp[0])), g1 = sigmoidf_(bflo((unsigned)gp[1])), g2 = sigmoidf_(bflo((unsigned)gp[2]));
    AttnWave W; AttnUnitDesc U;
    LAS u32x2* accl = (LAS u32x2*)(lds + ATT_ACC + wid * 4096) + lane;
    attn_init(W, lane, i0w, sl2, 1);
    load_q(W, big + ((size_t)b * SEQ + i0w) * QGP + head * 64, QGP, lane);
    {
        W.jlo = i0w - 511; W.jhi = i0w + 31; W.max_back = 511;
        const int slo = qb >= 8 ? qb - 8 : 0; W.j0 = 64 * qb;
        U.K = kvn + (size_t)(8 + g) * T * 64; U.V = kvn + (size_t)(10 + g) * T * 64; U.kvstride = 64; U.jclamp = SEQ - 1;
        U.stmask = ((qb == 63) ? ~0ull : ((2ull << qb) - 1ull)) & ~((1ull << slo) - 1ull);
        attn_run<AT_BAND, MD_ONLINE>(W, U, lds, tid, lane, nullptr, 0ull);
        const float lt = W.l + __shfl_xor(W.l, 32); const float sc = g2 / fmaxf(lt, 1e-30f);
#pragma unroll
        for (int blk = 0; blk < 2; ++blk)
#pragma unroll
            for (int i = 0; i < 4; ++i) { u32x2 w; w.x = pk2(W.o[blk][4 * i] * sc, W.o[blk][4 * i + 1] * sc); w.y = pk2(W.o[blk][4 * i + 2] * sc, W.o[blk][4 * i + 3] * sc); accl[(blk * 4 + i) * 64] = w; }
    }
    attn_init(W, lane, i0w, sl2, 16);
    {
        W.jlo = 0; W.jhi = i0w >> 4;
        const int cmax = 4 * qb + 2, shi = cmax >> 6; W.j0 = 64 * shi;
        U.K = (const bf16_t*)(a.ws + WS_KC) + (size_t)(b * 2 + g) * 256 * 64; U.V = (const bf16_t*)(a.ws + WS_VC) + (size_t)(b * 2 + g) * 256 * 64; U.kvstride = 64; U.jclamp = NCMP - 1;
        U.stmask = (2ull << shi) - 1ull;
        LAS float* impw = IMP + ((size_t)hl * 64 + 32 * (wid & 1) + (lane & 31)) * 65;
        attn_run<AT_CMP, MD_STATS>(W, U, lds, tid, lane, impw, 0ull);
        const float lt = W.l + __shfl_xor(W.l, 32);
        W.mfin = W.m; W.invl = 1.0f / fmaxf(lt, 1e-30f);
        attn_run<AT_CMP, MD_NORM>(W, U, lds, tid, lane, impw, 0ull);
#pragma unroll
        for (int blk = 0; blk < 2; ++blk)
#pragma unroll
            for (int i = 0; i < 4; ++i) { const u32x2 p = accl[(blk * 4 + i) * 64]; u32x2 w;
                w.x = pk2(bflo(p.x) + W.o[blk][4 * i] * g0, bfhi(p.x) + W.o[blk][4 * i + 1] * g0); w.y = pk2(bflo(p.y) + W.o[blk][4 * i + 2] * g0, bfhi(p.y) + W.o[blk][4 * i + 3] * g0); accl[(blk * 4 + i) * 64] = w; }
    }
    LAS unsigned long long* SELL = (LAS unsigned long long*)(lds + ATT_SELL);
    for (int qq = 8 * wid; qq < 8 * wid + 8; ++qq) {
        float val = ((IMP[(0 * 64 + qq) * 65 + lane] + IMP[(1 * 64 + qq) * 65 + lane]) + IMP[(2 * 64 + qq) * 65 + lane]) + IMP[(3 * 64 + qq) * 65 + lane];
        const int own = qb, j = lane;
        const bool forced = (j == 0) || (j == own) || (j == own - 1);
        const bool valid = j <= own;
        val = forced ? INFINITY : (valid ? val : -INFINITY);
        int rank = 0;
#pragma unroll
        for (int jj = 0; jj < 64; ++jj) { const float o = __builtin_bit_cast(float, __builtin_amdgcn_readlane(__builtin_bit_cast(int, val), jj)); rank += (o > val || (o == val && jj < j)) ? 1 : 0; }
        const unsigned long long msk = __ballot(rank < 16);
        if (lane == 0) SELL[qq] = msk;
    }
    __syncthreads();
    attn_init(W, lane, i0w, sl2, 1);
    {
        W.jlo = 0; W.jhi = i0w + 31; W.j0 = 64 * qb;
        W.mysel = SELL[32 * (wid & 1) + (lane & 31)];
        unsigned lo = (unsigned)W.mysel, hi = (unsigned)(W.mysel >> 32);
#pragma unroll
        for (int o = 1; o < 64; o <<= 1) { lo |= __shfl_xor(lo, o); hi |= __shfl_xor(hi, o); }
        const unsigned long long wm = ((unsigned long long)hi << 32) | lo;
        unsigned long long um = 0ull;
#pragma unroll
        for (int q = 0; q < 64; ++q) um |= SELL[q];
        const unsigned long long causal = (qb == 63) ? ~0ull : ((2ull << qb) - 1ull);
        um &= causal; um |= 1ull;
        U.K = kvn + (size_t)(4 + g) * T * 64; U.V = kvn + (size_t)(6 + g) * T * 64; U.kvstride = 64; U.jclamp = SEQ - 1; U.stmask = um;
        attn_run<AT_SEL, MD_ONLINE>(W, U, lds, tid, lane, nullptr, wm);
        const float lt = W.l + __shfl_xor(W.l, 32); const float sc = g1 / fmaxf(lt, 1e-30f);
        bf16_t* orow = (bf16_t*)(a.ws + WS_ONSA) + tok * 512 + head * 64;
        const int h = lane >> 5;
#pragma unroll
        for (int blk = 0; blk < 2; ++blk)
#pragma unroll
            for (int i = 0; i < 4; ++i) { const u32x2 p = accl[(blk * 4 + i) * 64]; u32x2 w;
                w.x = pk2(bflo(p.x) + W.o[blk][4 * i] * sc, bfhi(p.x) + W.o[blk][4 * i + 1] * sc); w.y = pk2(bflo(p.y) + W.o[blk][4 * i + 2] * sc, bfhi(p.y) + W.o[blk][4 * i + 3] * sc);
                *(u32x2*)(orow + 32 * blk + 8 * i + 4 * h) = w; }
    }
}

constexpr int LDS_BIAS = 131072;
__device__ __forceinline__ void unit_compress_full(const Args& a, int id, LAS unsigned char* lds, int tid_in) {
    const int which = id >> 4, b = (id >> 1) & 7, g = id & 1;
    LAS float* bias = (LAS float*)(lds + LDS_BIAS);
    int tid = tid_in; asm volatile("" : "+v"(tid));
    if (tid < 256) bias[tid] = ((const float*)(a.ws + WS_BIASP + 0x10000))[which * 256 + tid];
    __syncthreads();
    bf16_t* CH = (bf16_t*)(a.ws + WS_CH) + (size_t)id * 65536;
    {
        int K = 2048; asm volatile("" : "+s"(K));
        pg8::Gemm gm{(const bf16_t*)(a.ws + WS_BIG), (const bf16_t*)(a.ws + (which ? WS_WCV1 : WS_WCK1)), K, 16 * 64, 128, 2048};
        int one = 1; asm volatile("" : "+s"(one));
        pg8::OneUnit S{(KVN_OFF + ((size_t)(which * 2 + g) * T + (size_t)b * SEQ) * 64) * 2, one};
        pg8::Epi<pg8::EP_STORE> E{CH, 256, nullptr, nullptr, nullptr};
        pg8::gemm_phase<pg8::Epi<pg8::EP_STORE>, pg8::OneUnit, true>(lds, gm, S, E);
    }
    __threadfence();
    __syncthreads();
    tid = tid_in; asm volatile("" : "+v"(tid));
    {
        const int lane = tid & 63, wv = tid >> 6, fr = lane & 15, fq = lane >> 4;
        const bf16_t* w2t = (const bf16_t*)(a.ws + WS_SELM + (which ? 0x8000 : 0));
        f32x4 acc[2][4];
#pragma unroll
        for (int rt = 0; rt < 2; ++rt)
#pragma unroll
            for (int ct = 0; ct < 4; ++ct) acc[rt][ct] = (f32x4){0.f, 0.f, 0.f, 0.f};
        for (int ks = 0; ks < 8; ++ks) {
            const int k0 = 32 * ks + 8 * fq;
            const f32x4 b0 = *(const LAS f32x4*)(bias + k0), b1 = *(const LAS f32x4*)(bias + k0 + 4);
            bf16x8 af[2], bfr[4];
#pragma unroll
            for (int rt = 0; rt < 2; ++rt) {
                const u32x4 hv = *(const u32x4*)(CH + (size_t)(32 * wv + 16 * rt + fr) * 256 + k0);
                float hx[8] = {bflo(hv.x) + b0.x, bfhi(hv.x) + b0.y, bflo(hv.y) + b0.z, bfhi(hv.y) + b0.w, bflo(hv.z) + b1.x, bfhi(hv.z) + b1.y, bflo(hv.w) + b1.z, bfhi(hv.w) + b1.w};
#pragma unroll
                for (int e = 0; e < 8; ++e) { const float x = hx[e]; const float z = 0.7978845608028654f * (x + 0.044715f * x * x * x); hx[e] = x * sigmoidf_(2.0f * z); }
                u32x4 w; w.x = pk2(hx[0], hx[1]); w.y = pk2(hx[2], hx[3]); w.z = pk2(hx[4], hx[5]); w.w = pk2(hx[6], hx[7]);
                af[rt] = __builtin_bit_cast(bf16x8, w);
            }
#pragma unroll
            for (int ct = 0; ct < 4; ++ct) bfr[ct] = *(const bf16x8*)(w2t + (size_t)(16 * ct + fr) * 256 + k0);
#pragma unroll
            for (int rt = 0; rt < 2; ++rt)
#pragma unroll
                for (int ct = 0; ct < 4; ++ct) acc[rt][ct] = __builtin_amdgcn_mfma_f32_16x16x32_bf16(bfr[ct], af[rt], acc[rt][ct], 0, 0, 0);
        }
        bf16_t* obase = (bf16_t*)(a.ws + (which ? WS_VC : WS_KC)) + (size_t)(b * 2 + g) * 256 * 64;
#pragma unroll
        for (int rt = 0; rt < 2; ++rt) { const int c = 32 * wv + 16 * rt + fr;
            if (c < NCMP) {
#pragma unroll
                for (int ct = 0; ct < 4; ++ct) { u32x2 w; w.x = pk2(acc[rt][ct][0], acc[rt][ct][1]); w.y = pk2(acc[rt][ct][2], acc[rt][ct][3]); *(u32x2*)(obase + (size_t)c * 64 + 16 * ct + 4 * fq) = w; }
            } }
    }
    __syncthreads();
}

__device__ __forceinline__ void dil_combine(const Args& a, int gtid, int ngt) {
    const bf16_t* odg = (const bf16_t*)(a.ws + WS_Y); const float* lse = (const float*)(a.ws + WS_LSE); bf16_t* od = (bf16_t*)(a.ws + WS_ODIL);
    for (size_t it = gtid; it < (size_t)T * 32; it += ngt) {
        const size_t tok = it >> 5; const int c8 = (int)(it & 31), hi = c8 >> 3;
        const float l0 = lse[tok * 4 + hi], l1 = lse[((size_t)T + tok) * 4 + hi], l2 = lse[((size_t)2 * T + tok) * 4 + hi];
        const float mx = fmaxf(l0, fmaxf(l1, l2));
        float w0 = __expf(l0 - mx), w1 = __expf(l1 - mx), w2 = __expf(l2 - mx); const float inv = 1.0f / (w0 + w1 + w2); w0 *= inv; w1 *= inv; w2 *= inv;
        const u32x4 p0 = *(const u32x4*)(odg + tok * 256 + c8 * 8), p1 = *(const u32x4*)(odg + ((size_t)T + tok) * 256 + c8 * 8), p2 = *(const u32x4*)(odg + ((size_t)2 * T + tok) * 256 + c8 * 8);
        u32x4 o;
        o.x = pk2(w0 * bflo(p0.x) + w1 * bflo(p1.x) + w2 * bflo(p2.x), w0 * bfhi(p0.x) + w1 * bfhi(p1.x) + w2 * bfhi(p2.x));
        o.y = pk2(w0 * bflo(p0.y) + w1 * bflo(p1.y) + w2 * bflo(p2.y), w0 * bfhi(p0.y) + w1 * bfhi(p1.y) + w2 * bfhi(p2.y));
        o.z = pk2(w0 * bflo(p0.z) + w1 * bflo(p1.z) + w2 * bflo(p2.z), w0 * bfhi(p0.z) + w1 * bfhi(p1.z) + w2 * bfhi(p2.z));
        o.w = pk2(w0 * bflo(p0.w) + w1 * bflo(p1.w) + w2 * bflo(p2.w), w0 * bfhi(p0.w) + w1 * bfhi(p1.w) + w2 * bfhi(p2.w));
        *(u32x4*)(od + tok * 256 + c8 * 8) = o;
    }
}


#define XB_TMO      128
#define XB_XCNT(j)  (256  + 64 * (j))
#define XB_XSUB(j)  (1280 + 64 * (j))
#define XB_XGEN(j)  (2304 + 64 * (j))
#define XB_TOP      3328
#define XB_TOPGEN   3392
#define XCD_BAR_WORDS 3456
#define XB_SPIN_CAP (1u << 18)
__device__ __forceinline__ unsigned xb_ld(unsigned* p)              { return __hip_atomic_load(p, __ATOMIC_RELAXED, __HIP_MEMORY_SCOPE_AGENT); }
__device__ __forceinline__ unsigned xb_add(unsigned* p, unsigned v) { return __hip_atomic_fetch_add(p, v, __ATOMIC_RELAXED, __HIP_MEMORY_SCOPE_AGENT); }
__device__ __forceinline__ unsigned xb_xcc_id() { return (unsigned)__builtin_amdgcn_s_getreg((3 << 11) | 20) & 0xFu; }
#define XB_SPIN(cond, bar) do { unsigned _sp = 0; while (cond) { __builtin_amdgcn_s_sleep(1); \
    if ((++_sp & 255u) == 0u) { if (xb_ld(&(bar)[XB_TMO])) break; if (_sp > XB_SPIN_CAP) { atomicAdd(&(bar)[XB_TMO], 1u); break; } } } } while (0)
struct XcdBarrier { unsigned* bar; unsigned x; volatile LAS unsigned* st; };
__device__ __forceinline__ XcdBarrier xcd_barrier_post(unsigned* bar, volatile LAS unsigned* st) {
    XcdBarrier b; b.bar = bar; b.x = xb_xcc_id(); b.st = st;
    if (threadIdx.x == 0) (void)xb_add(&bar[XB_XCNT(b.x)], 1u);
    return b;
}
__device__ __forceinline__ void xcd_barrier_complete(unsigned* bar, unsigned x, unsigned& nloc, unsigned& nx) {
    const unsigned G = gridDim.x * gridDim.y * gridDim.z;
    unsigned sum, cnt, mine, sp = 0u;
    for (;;) {
        sum = 0u; cnt = 0u; mine = 0u;
#pragma unroll
        for (unsigned j = 0; j < 16; ++j) { const unsigned c = xb_ld(&bar[XB_XCNT(j)]); sum += c; cnt += (c > 0u) ? 1u : 0u; mine = (j == x) ? c : mine; }
        if (sum == G) break;
        __builtin_amdgcn_s_sleep(1);
        if ((++sp & 255u) == 0u) { if (xb_ld(&bar[XB_TMO])) break; if (sp > XB_SPIN_CAP) { atomicAdd(&bar[XB_TMO], 1u); break; } }
    }
    nloc = mine > 0u ? mine : 1u; nx = cnt > 0u ? cnt : 1u;
}
__device__ __forceinline__ void xcd_barrier(const XcdBarrier& b) {
    asm volatile("s_waitcnt vmcnt(0)" ::: "memory");
    __syncthreads();
    if (threadIdx.x == 0) {
        unsigned* bar = b.bar;
        __builtin_amdgcn_s_waitcnt(0);
        unsigned nloc = b.st[0], nx = b.st[1];
        if (nloc == 0u) { xcd_barrier_complete(bar, b.x, nloc, nx); b.st[0] = nloc; b.st[1] = nx; }
        const unsigned old = xb_add(&bar[XB_XSUB(b.x)], 1u);
        const unsigned gen = old / nloc;
        if (old + 1u == (gen + 1u) * nloc) {
            __builtin_amdgcn_fence(__ATOMIC_RELEASE, "agent");
            asm volatile("s_waitcnt vmcnt(0)" ::: "memory");
            const unsigned og = xb_add(&bar[XB_TOP], 1u);
            const unsigned tg = og / nx;
            if (og + 1u == (tg + 1u) * nx) xb_add(&bar[XB_TOPGEN], 1u);
            else XB_SPIN(xb_ld(&bar[XB_TOPGEN]) == tg, bar);
            __builtin_amdgcn_fence(__ATOMIC_ACQUIRE, "agent");
            xb_add(&bar[XB_XGEN(b.x)], 1u);
            asm volatile("s_waitcnt vmcnt(0)" ::: "memory");
        } else {
            XB_SPIN(xb_ld(&bar[XB_XGEN(b.x)]) == gen, bar);
            __builtin_amdgcn_fence(__ATOMIC_ACQUIRE, "agent");
            asm volatile("s_waitcnt vmcnt(0)" ::: "memory");
        }
    }
    __syncthreads();
}

constexpr int NPHASE = 13;
constexpr int LDS_BYTES = 147456;
template <int MODE>
__device__ __forceinline__ void run_gemm(LAS unsigned char* lds, const bf16_t* A, const bf16_t* Bt, int N, int K, bf16_t* O, int ldc, const bf16_t* P1, const bf16_t* P2) {
    asm volatile("" : "+s"(K));
    pg8::Gemm g{A, Bt, K, K, pg8::BK * 2, K};
    pg8::StaticOrder S; S.init(T, N, (int)gridDim.x, (int)blockIdx.x, K);
    pg8::Epi<MODE> E{O, ldc, P1, P2, nullptr};
    pg8::gemm_phase<pg8::Epi<MODE>, pg8::StaticOrder, true>(lds, g, S, E);
}

__global__ void __launch_bounds__(512, 2) mk_fwd(Args a) {
    extern __shared__ __attribute__((aligned(16))) unsigned char lds_raw[];
    LAS unsigned char* lds = (LAS unsigned char*)lds_raw;
    const int G = gridDim.x, bid = blockIdx.x;
#define IDS() int tid = threadIdx.x; asm volatile("" : "+v"(tid)); const int lane = tid & 63, wid = __builtin_amdgcn_readfirstlane(tid >> 6); const int gw = bid * 8 + wid, ngw = G * 8; (void)gw; (void)ngw; (void)lane

    unsigned char* ws = a.ws;
    bf16_t* H = (bf16_t*)(ws + WS_H); bf16_t* Y = (bf16_t*)(ws + WS_Y); bf16_t* BIG = (bf16_t*)(ws + WS_BIG);
    cg::grid_group grid = cg::this_grid();
    if (a.ph_lo < 0) grid.sync();
    volatile LAS unsigned* MISCW = (volatile LAS unsigned*)(lds + LDS_BYTES - 64);
    if (threadIdx.x < 4) MISCW[threadIdx.x] = 0u;
    __syncthreads();
    XcdBarrier bar; bar.bar = (unsigned*)ws; bar.x = 0; bar.st = MISCW;
    if (a.ph_hi - a.ph_lo > 1) bar = xcd_barrier_post((unsigned*)ws, MISCW);
#ifndef PHASE_MASK
#define PHASE_MASK 0xFFFFF
#endif
#define IN(k) ((((PHASE_MASK) >> (k)) & 1) && a.ph_lo <= (k) && (k) < a.ph_hi)
#ifndef REPEAT_MASK
#define REPEAT_MASK 0
#endif
#define REP(k) for (int rep_ = 0; rep_ < ((((REPEAT_MASK) >> (k)) & 1) ? 2 : 1); ++rep_)
#define SEAM(k) do { if (IN(k) && IN((k) + 1)) xcd_barrier(bar); } while (0)

    if (IN(0)) REP(0) {
        IDS();
        int base = 0;
        for (int m = 0; m < W_NMAT; ++m) {
            const MatDesc md = mat_desc(m); const int nit = (md.K / 64) * (md.Nd / 64);
            int first = (gw - base % ngw + ngw) % ngw;
            for (int it = first; it < nit; it += ngw) transpose_item(a, m, it, lane);
            base += nit;
        }
        for (int t = gw; t < 64; t += ngw) {
            const int which = t >> 5, ch = t & 31; const float* pe = a.in[which ? 12 : 9]; const float* w1 = a.in[which ? 13 : 10];
            float s[4] = {0.f, 0.f, 0.f, 0.f};
            for (int k = 64 * ch; k < 64 * ch + 64; ++k) { const float p = pe[k];
#pragma unroll
                for (int j = 0; j < 4; ++j) s[j] += p * w1[(size_t)k * 256 + lane + 64 * j]; }
#pragma unroll
            for (int j = 0; j < 4; ++j) ((float*)(ws + WS_BIASP))[(size_t)t * 256 + lane + 64 * j] = s[j];
        }
        row_pass<false, false>(a.in[0], nullptr, 0.f, nullptr, nullptr, a.in[1], H, gw, ngw, lane);
    }
    SEAM(0);
#ifndef EXTRA_SYNC
#define EXTRA_SYNC 0
#endif
    for (int es_ = 0; es_ < EXTRA_SYNC; ++es_) xcd_barrier(bar);
    if (IN(1)) REP(1) run_gemm<pg8::EP_SWIGLU>(lds, H, (const bf16_t*)(ws + WS_WGU1), NGU, D, BIG, FF, nullptr, nullptr);
    SEAM(1);
    if (IN(2)) REP(2) run_gemm<pg8::EP_STORE>(lds, BIG, (const bf16_t*)(ws + WS_WD1), D, FF, Y, D, nullptr, nullptr);
    SEAM(2);
    if (IN(3)) REP(3) { IDS(); row_pass<false, true>(a.in[0], Y, 0.5f, a.in[2], a.out, a.in[6], H, gw, ngw, lane);
        if (bid == 0) { const float* bp = (const float*)(ws + WS_BIASP) + (size_t)(tid >> 8) * 32 * 256 + (tid & 255); float sbias = 0.f;
            for (int c = 0; c < 32; ++c) sbias += bp[c * 256];
            ((float*)(ws + WS_BIASP + 0x10000))[tid] = sbias; } }
    SEAM(3);
    if (IN(4)) REP(4) run_gemm<pg8::EP_PROJ>(lds, H, (const bf16_t*)(ws + WS_WIN), PITCH, D, BIG, PITCH, nullptr, nullptr);
    SEAM(4);
    if (IN(5)) REP(5) {
        { int tid0 = threadIdx.x; asm volatile("" : "+v"(tid0)); for (int u = bid; u < 32; u += G) unit_compress_full(a, u, lds, tid0); }
        IDS();
        int first, nmine, stride = 1;
        if (G == 256) {
            if (bid < 32) { first = 0; nmine = 0; }
            else { const int w = bid - 32; if (w < 192) { first = 7 * w; nmine = 7; } else { first = 1344 + 6 * (w - 192); nmine = 6; } }
        } else { first = bid; stride = G; nmine = bid < 1536 ? (1536 - bid + G - 1) / G : 0; }
        for (int k = 0; k < nmine; ++k) unit_dilated(a, first + k * stride, lds, tid, wid, lane);
    }
    SEAM(5);
    if (IN(6)) REP(6) {
        IDS();
        if (G == 256) {
            const int x = bid & 7, j = bid >> 3;
            for (int k = 0; k < 4; ++k) { const int p = x + 8 * (k >> 1); unit_nsa(a, p >> 1, p & 1, (k & 1) ? 63 - j : j, lds, tid, wid, lane); }
        } else { for (int u = bid; u < 1024; u += G) { int b, g, qb; gqa_decode(u, b, g, qb); unit_nsa(a, b, g, qb, lds, tid, wid, lane); } }
        dil_combine(a, bid * 512 + tid, G * 512);
    }
    SEAM(6);
    if (IN(7)) REP(7) {
        run_gemm<pg8::EP_SIG>(lds, H, (const bf16_t*)(ws + WS_WGA), D, D, Y, D, nullptr, nullptr);
        run_gemm<pg8::EP_MUL>(lds, (const bf16_t*)(ws + WS_ONSA), (const bf16_t*)(ws + WS_WN), D, 512, Y, D, Y, nullptr);
        run_gemm<pg8::EP_SIG>(lds, H, (const bf16_t*)(ws + WS_WGB), D, D, BIG, D, nullptr, nullptr);
        run_gemm<pg8::EP_FINAL>(lds, (const bf16_t*)(ws + WS_ODIL), (const bf16_t*)(ws + WS_WDIL), D, 256, Y, D, Y, BIG);
    }
    SEAM(7);
    if (IN(8)) REP(8) run_gemm<pg8::EP_STORE>(lds, Y, (const bf16_t*)(ws + WS_WMIX), D, D, BIG + (size_t)32 * MiB, D, nullptr, nullptr);
    SEAM(8);
    if (IN(9)) REP(9) { IDS(); row_pass<true, true>(a.out, BIG + (size_t)32 * MiB, 1.0f, a.in[7], ws + WS_ONSA, a.in[18], H, gw, ngw, lane); }
    SEAM(9);
    if (IN(10)) REP(10) run_gemm<pg8::EP_SWIGLU>(lds, H, (const bf16_t*)(ws + WS_WGU2), NGU, D, BIG, FF, nullptr, nullptr);
    SEAM(10);
    if (IN(11)) REP(11) run_gemm<pg8::EP_STORE>(lds, BIG, (const bf16_t*)(ws + WS_WD2), D, FF, Y, D, nullptr, nullptr);
    SEAM(11);
    if (IN(12)) REP(12) { IDS(); row_pass<true, false>(ws + WS_ONSA, Y, 0.5f, a.in[19], a.out, nullptr, nullptr, gw, ngw, lane); }
#undef IN
#undef SEAM
}

#ifndef MK_ONE_LAUNCH
#define MK_ONE_LAUNCH 1
#endif
extern "C" void kernel_launch(void* const* d_in, const int* in_sizes, int n_in, void* d_out, int out_size, void* d_ws, size_t ws_size, hipStream_t stream) {
    static int grid = 0;
    if (grid == 0) {
        if (n_in != 23 || ws_size < WS_END) { fprintf(stderr, "kernel_launch: unexpected n_in %d / ws_size %zu\n", n_in, ws_size); grid = -1; return; }
        int dev = 0, cus = 0, per_cu = 0;
        hipGetDevice(&dev); hipDeviceGetAttribute(&cus, hipDeviceAttributeMultiprocessorCount, dev);
        hipFuncSetAttribute((const void*)mk_fwd, hipFuncAttributeMaxDynamicSharedMemorySize, LDS_BYTES);
        hipOccupancyMaxActiveBlocksPerMultiprocessor(&per_cu, (const void*)mk_fwd, 512, LDS_BYTES);
        if (per_cu < 1) { fprintf(stderr, "kernel_launch: occupancy query returned %d\n", per_cu); per_cu = 1; }
        (void)hipGetLastError();
        grid = cus * 1;
    }
    if (grid < 0) return;
    if (hipMemsetAsync(d_ws, 0, 16384, stream) != hipSuccess) fprintf(stderr, "kernel_launch: memset failed\n");
    Args a{};
    for (int i = 0; i < 23; ++i) a.in[i] = (const float*)d_in[i];
    a.out = (float*)d_out; a.ws = (unsigned char*)d_ws;
#if MK_ONE_LAUNCH
    a.ph_lo = 0; a.ph_hi = NPHASE;
    void* args[] = {&a};
    hipError_t e = hipLaunchCooperativeKernel((const void*)mk_fwd, dim3(grid), dim3(512), args, LDS_BYTES, stream);
    if (e != hipSuccess) fprintf(stderr, "cooperative launch failed: %s (grid %d)\n", hipGetErrorString(e), grid);
#else
    for (int p = 0; p < NPHASE; ++p) { a.ph_lo = p; a.ph_hi = p + 1; hipLaunchKernelGGL(mk_fwd, dim3(grid), dim3(512), LDS_BYTES, stream, a); }
#endif
}
```

```cpp
#include <hip/hip_runtime.h>
#include <hip/hip_cooperative_groups.h>
#include <cstdio>
#include <cstdint>
namespace cg = cooperative_groups;

#define LAS __attribute__((address_space(3)))
typedef unsigned short bf16_t;
typedef short bf16x8 __attribute__((ext_vector_type(8)));
typedef short s16x4 __attribute__((ext_vector_type(4)));
typedef float f32x2 __attribute__((ext_vector_type(2)));
typedef float f32x4 __attribute__((ext_vector_type(4)));
typedef float f32x16 __attribute__((ext_vector_type(16)));
typedef unsigned u32x2 __attribute__((ext_vector_type(2)));
typedef unsigned u32x4 __attribute__((ext_vector_type(4)));

constexpr int BATCH = 8, SEQ = 4096, T = BATCH * SEQ, D = 1024, FF = 2816, NGU = 2 * FF;
constexpr int IN_DIM = 5656;
constexpr int PITCH = 3840;
constexpr int C_QN = 0, C_KV = 512, C_DIL = 1280, C_GN = 3584;
constexpr int NCMP = 255;
constexpr int QGP = 576;
constexpr size_t KVN_OFF = (size_t)T * QGP, DILS_OFF = KVN_OFF + (size_t)12 * T * 64;
constexpr float LOG2E = 1.4426950408889634f;
constexpr float RMS_EPS = 1e-6f;

constexpr size_t MiB = 1u << 20;
constexpr size_t WS_WGU1 = 2 * MiB, WS_WD1 = 13 * MiB, WS_WGU2 = 19 * MiB, WS_WD2 = 30 * MiB, WS_WIN = 36 * MiB;
constexpr size_t WS_WGA = 44 * MiB, WS_WGB = 46 * MiB, WS_WN = 48 * MiB, WS_WDIL = 49 * MiB, WS_WMIX = 50 * MiB;
constexpr size_t WS_WCK1 = 52 * MiB, WS_WCV1 = 53 * MiB;
constexpr size_t WS_BIASP = 54 * MiB, WS_KC = 54 * MiB + 0x20000, WS_VC = 54 * MiB + 0xA0000, WS_SELM = 54 * MiB + 0x120000;
constexpr size_t WS_CH = 56 * MiB, WS_H = 60 * MiB, WS_Y = 124 * MiB, WS_BIG = 188 * MiB, WS_ONSA = 428 * MiB, WS_ODIL = 460 * MiB;
constexpr size_t WS_END = 476 * MiB;
constexpr size_t WS_LSE = WS_Y + 48 * MiB;

__device__ __forceinline__ unsigned f2bf(float f) { unsigned u = __builtin_bit_cast(unsigned, f); return (u + 0x7fffu + ((u >> 16) & 1u)) >> 16; }
typedef __bf16 bf16x2_t __attribute__((ext_vector_type(2)));
__device__ __forceinline__ unsigned pk2(float lo, float hi) { f32x2 v = {lo, hi}; return __builtin_bit_cast(unsigned, __builtin_convertvector(v, bf16x2_t)); }
__device__ __forceinline__ float bflo(unsigned w) { return __builtin_bit_cast(float, w << 16); }
__device__ __forceinline__ float bfhi(unsigned w) { return __builtin_bit_cast(float, w & 0xffff0000u); }
__device__ __forceinline__ float sigmoidf_(float x) { return __builtin_amdgcn_rcpf(1.0f + __builtin_amdgcn_exp2f(-1.4426950408889634f * x)); }
__device__ __forceinline__ float wave_sum(float v) {
#pragma unroll
    for (int o = 1; o < 64; o <<= 1) v += __shfl_xor(v, o);
    return v;
}

namespace pg8 {
constexpr int BM = 256, BK = 64, HALF = 128, HTB = HALF * BK * 2, STAGE_BYTES = 8 * HTB, NXCD = 8, WGM = 8;
__host__ __device__ __forceinline__ int lds_byte(int r, int c) { const int st = (r >> 4) * 2 + (c >> 5), rr = r & 15, cc = c & 31, ob = rr * 64 + cc * 2; return st * 1024 + (ob ^ (((ob >> 9) & 1) << 5)); }
__host__ __device__ __forceinline__ void stage_rc(int b, int& R, int& C) { const int st = b / 1024, sb = b % 1024, swz = sb ^ (((sb >> 9) & 1) << 5); R = (st >> 1) * 16 + swz / 64; C = (st & 1) * 32 + (swz % 64) / 2; }
__host__ __device__ __forceinline__ int perm32(int rho) { const int n = rho >> 4, i = rho & 15; return 8 * (i >> 2) + 4 * n + (i & 3); }

struct Unit { int pm, pn; };
struct Gemm { const bf16_t* A; const bf16_t* Bt; int K; int lda; int kstepA; int ldb; };

struct StaticOrder {
    int nM, nN, nwg, G, c; size_t tstepA;
    __device__ void init(int M, int N, int G_, int c_, int lda) { nM = M / BM; nN = N / BM; nwg = nM * nN; G = G_; c = c_; tstepA = (size_t)BM * lda * 2; }
    __device__ bool next(int i, Unit& u) const {
        const long L = (long)i * G + c; if (L >= nwg) return false;
        int wgid = (int)L; { const int q = nwg / NXCD, r = nwg % NXCD, xcd = wgid % NXCD, off = wgid / NXCD; wgid = (xcd < r ? xcd * (q + 1) : r * (q + 1) + (xcd - r) * q) + off; }
        const int nig = WGM * nN, gid = wgid / nig, fm = gid * WGM, gsz = (nM - fm) < WGM ? (nM - fm) : WGM;
        u.pm = fm + ((wgid % nig) % gsz); u.pn = (wgid % nig) / gsz; return true;
    }
    __device__ __forceinline__ size_t aoff(const Unit& u) const { return (size_t)u.pm * tstepA; }
};
struct OneUnit {
    size_t off; int n;
    __device__ bool next(int i, Unit& u) const { if (i >= n) return false; u.pm = 0; u.pn = 0; return true; }
    __device__ __forceinline__ size_t aoff(const Unit&) const { return off; }
};

enum { EP_STORE = 0, EP_SIG = 1, EP_MUL = 2, EP_FINAL = 3, EP_SWIGLU = 4, EP_GELU = 5, EP_PROJ = 6 };
template <int MODE> struct Epi {
    static constexpr bool PERM = true;
    bf16_t* O; int ldc; const bf16_t* P1; const bf16_t* P2; const LAS float* bias;
    __device__ __forceinline__ void operator()(const f32x4 (&acc)[2][2][4][2], const Unit& u, int wr, int wc, int fr, int fq) const {
        const int row0 = u.pm * BM + wr * 64 + fr; const int col0 = u.pn * BM + wc * 32 + 8 * fq;
#pragma unroll
        for (int ai = 0; ai < 2; ++ai)
#pragma unroll
            for (int m = 0; m < 4; ++m) {
                const size_t rbase = (size_t)(row0 + ai * HALF + m * 16);
#pragma unroll
                for (int bj = 0; bj < 2; ++bj) {
                    f32x4 v0 = acc[ai][bj][m][0], v1 = acc[ai][bj][m][1];
                    const int col = col0 + bj * HALF;
                    if (MODE == EP_SWIGLU) {
                        u32x2 w; float r[4];
#pragma unroll
                        for (int e = 0; e < 4; ++e) { const float g = v0[e]; r[e] = g * sigmoidf_(g) * v1[e]; }
                        w.x = pk2(r[0], r[1]); w.y = pk2(r[2], r[3]);
                        *(u32x2*)(O + rbase * ldc + (col >> 1)) = w;
                    } else {
                        float r[8] = {v0[0], v0[1], v0[2], v0[3], v1[0], v1[1], v1[2], v1[3]};
                        size_t off = rbase * ldc + col;
                        if (MODE == EP_PROJ) {
                            const int row = (int)rbase;
                            if (u.pn < 2) off = rbase * QGP + col;
                            else if (u.pn < 5) off = KVN_OFF + ((size_t)((col - 512) >> 6) * T + row) * 64 + (col & 63);
                            else if (u.pn < 14) { const int c2 = col - 1280, slab = c2 >> 6, hd = slab % 12, sh = (hd >> 2) * 2  ;
                                const int sq = row & (SEQ - 1), sp = ((sq & ((1 << sh) - 1)) << (12 - sh)) + (sq >> sh);
                                off = DILS_OFF + ((size_t)slab * T + (row & ~(SEQ - 1)) + sp) * 64 + (col & 63); }
                            else { if (col - 3584 >= 64) continue; off = rbase * QGP + 512 + (col - 3584); }
                        }
                        if (MODE == EP_SIG) {
#pragma unroll
                            for (int e = 0; e < 8; ++e) r[e] = sigmoidf_(r[e]);
                        } else if (MODE == EP_MUL) {
                            const u32x4 p = *(const u32x4*)(P1 + off);
                            r[0] *= bflo(p.x); r[1] *= bfhi(p.x); r[2] *= bflo(p.y); r[3] *= bfhi(p.y); r[4] *= bflo(p.z); r[5] *= bfhi(p.z); r[6] *= bflo(p.w); r[7] *= bfhi(p.w);
                        } else if (MODE == EP_FINAL) {
                            const u32x4 p = *(const u32x4*)(P1 + off); const u32x4 q = *(const u32x4*)(P2 + off);
                            r[0] = bflo(p.x) + bflo(q.x) * r[0]; r[1] = bfhi(p.x) + bfhi(q.x) * r[1]; r[2] = bflo(p.y) + bflo(q.y) * r[2]; r[3] = bfhi(p.y) + bfhi(q.y) * r[3];
                            r[4] = bflo(p.z) + bflo(q.z) * r[4]; r[5] = bfhi(p.z) + bfhi(q.z) * r[5]; r[6] = bflo(p.w) + bflo(q.w) * r[6]; r[7] = bfhi(p.w) + bfhi(q.w) * r[7];
                        } else if (MODE == EP_GELU) {
#pragma unroll
                            for (int e = 0; e < 8; ++e) { const float x = r[e] + bias[col + e]; const float z = 0.7978845608028654f * (x + 0.044715f * x * x * x); r[e] = x * sigmoidf_(2.0f * z); }
                        }
                        u32x4 w; w.x = pk2(r[0], r[1]); w.y = pk2(r[2], r[3]); w.z = pk2(r[4], r[5]); w.w = pk2(r[6], r[7]);
                        *(u32x4*)(O + off) = w;
                    }
                    asm volatile("" ::: "memory");
                }
            }
    }
};

template <class EpiT, class Sched, bool ALIGN_EPI>
__device__ __forceinline__ void gemm_phase(LAS unsigned char* lds, const Gemm g, const Sched& S, const EpiT& E) {
    int tid_ = threadIdx.x; asm volatile("" : "+v"(tid_));
    const int tid = tid_, wid = __builtin_amdgcn_readfirstlane(tid >> 6), lane = tid & 63, wr = wid >> 2, wc = wid & 3, fr = lane & 15, fq = lane >> 4;
    const int K = g.K, nt = K / BK;
    unsigned voffA[2], voffB[2];
#pragma unroll
    for (int i = 0; i < 2; ++i) { int R, C; stage_rc(tid * 16 + i * 8192, R, C); const int Rb = EpiT::PERM ? ((R & ~31) + perm32(R & 31)) : R;
        voffA[i] = (unsigned)(R * g.lda + C) * 2u; voffB[i] = (unsigned)(Rb * g.ldb + C) * 2u; }
    const size_t kstepA = (size_t)g.kstepA, kstepB = (size_t)(BK * 2);
    const size_t hstepA = (size_t)HALF * g.lda * 2, hstepB = (size_t)HALF * g.ldb * 2, tstepB = 2 * hstepB;
    const unsigned ldsw = (unsigned)wid * 1024u;
    const int aoff = lds_byte(wr * 64 + fr, fq * 8), boff = lds_byte(wc * 32 + fr, fq * 8);
#define PG8_SA(b, h) (((b) * 2 + (h)) * HTB)
#define PG8_SB(b, h) ((4 + (b) * 2 + (h)) * HTB)
#define PG8_STAGE(bufoff, gbase, voff) do { _Pragma("unroll") for (int _i = 0; _i < 2; ++_i) \
        __builtin_amdgcn_global_load_lds((const unsigned*)((const char*)(gbase) + (voff)[_i]), (LAS unsigned*)(lds + (bufoff) + ldsw + _i * 8192), 16, 0, 0); } while (0)
#define PG8_LDA(dst, b, h) do { _Pragma("unroll") for (int m = 0; m < 4; ++m) _Pragma("unroll") for (int k = 0; k < 2; ++k) dst[m][k] = *(const LAS bf16x8*)(lds + PG8_SA(b, h) + aoff + m * 2048 + k * 1024); } while (0)
#define PG8_LDB(dst, b, h) do { _Pragma("unroll") for (int n = 0; n < 2; ++n) _Pragma("unroll") for (int k = 0; k < 2; ++k) dst[n][k] = *(const LAS bf16x8*)(lds + PG8_SB(b, h) + boff + n * 2048 + k * 1024); } while (0)
#define PG8_MMA(ai, bj, At, Bt) do { __builtin_amdgcn_s_setprio(1); _Pragma("unroll") for (int m = 0; m < 4; ++m) _Pragma("unroll") for (int n = 0; n < 2; ++n) _Pragma("unroll") for (int k = 0; k < 2; ++k) \
        acc[ai][bj][m][n] = __builtin_amdgcn_mfma_f32_16x16x32_bf16(Bt[n][k], At[m][k], acc[ai][bj][m][n], 0, 0, 0); __builtin_amdgcn_s_setprio(0); } while (0)
#define PG8_WAIT_V(n) asm volatile("s_waitcnt vmcnt(" #n ")" ::: "memory")
#define PG8_WAIT_L(n) asm volatile("s_waitcnt lgkmcnt(" #n ")" ::: "memory")
#define PG8_BAR __builtin_amdgcn_s_barrier()
#define PG8_SCHED __builtin_amdgcn_sched_barrier(0)
    Unit cur, nxt; int ui = 0;
    if (!S.next(0, cur)) return;
    f32x4 acc[2][2][4][2];
#pragma unroll
    for (int a = 0; a < 2; ++a)
#pragma unroll
        for (int b = 0; b < 2; ++b)
#pragma unroll
            for (int m = 0; m < 4; ++m)
#pragma unroll
                for (int n = 0; n < 2; ++n) acc[a][b][m][n] = (f32x4){0.f, 0.f, 0.f, 0.f};
    bf16x8 At[4][2], B0[2][2], B1[2][2];
    const char* cA = (const char*)g.A + S.aoff(cur); const char* cB = (const char*)g.Bt + (size_t)cur.pn * tstepB;
    PG8_STAGE(PG8_SB(0, 0), cB, voffB); PG8_STAGE(PG8_SB(0, 1), cB + hstepB, voffB); PG8_STAGE(PG8_SA(0, 0), cA, voffA); PG8_STAGE(PG8_SA(0, 1), cA + hstepA, voffA);
    if (wr == 1) PG8_BAR;
    PG8_WAIT_V(2); PG8_BAR;
    PG8_STAGE(PG8_SB(1, 0), cB + kstepB, voffB); PG8_STAGE(PG8_SA(1, 0), cA + kstepA, voffA); PG8_STAGE(PG8_SB(1, 1), cB + hstepB + kstepB, voffB);
    PG8_WAIT_V(6); PG8_BAR;
    for (;;) {
        const bool has_next = S.next(ui + 1, nxt);
        const char* nA = has_next ? (const char*)g.A + S.aoff(nxt) : cA; const char* nB = has_next ? (const char*)g.Bt + (size_t)nxt.pn * tstepB : cB;
        for (int t = 0; t < nt; t += 2) {
            const bool last = (t == nt - 2);
            const char* a1 = cA + (size_t)(t + 1) * kstepA;
            const char* a2 = last ? nA : cA + (size_t)(t + 2) * kstepA; const char* b2 = last ? nB : cB + (size_t)(t + 2) * kstepB;
            const char* a3 = a2 + kstepA; const char* b3 = b2 + kstepB;
            PG8_LDB(B0, 0, 0); PG8_LDB(B1, 0, 1); PG8_SCHED; PG8_LDA(At, 0, 0); PG8_STAGE(PG8_SA(1, 1), a1 + hstepA, voffA);
            PG8_WAIT_V(8); PG8_WAIT_L(0); PG8_BAR; PG8_MMA(0, 0, At, B0); PG8_MMA(0, 1, At, B1); PG8_BAR; PG8_SCHED;
            PG8_LDA(At, 0, 1); PG8_STAGE(PG8_SB(0, 0), b2, voffB); PG8_STAGE(PG8_SB(0, 1), b2 + hstepB, voffB); PG8_STAGE(PG8_SA(0, 0), a2, voffA);
            PG8_WAIT_V(8); PG8_WAIT_L(0); PG8_BAR; PG8_MMA(1, 0, At, B0); PG8_MMA(1, 1, At, B1); PG8_BAR; PG8_SCHED;
            PG8_LDB(B0, 1, 0); PG8_LDB(B1, 1, 1); PG8_SCHED; PG8_LDA(At, 1, 0); PG8_STAGE(PG8_SA(0, 1), a2 + hstepA, voffA);
            PG8_WAIT_V(8); PG8_WAIT_L(0); PG8_BAR; PG8_MMA(0, 0, At, B0); PG8_MMA(0, 1, At, B1); PG8_BAR; PG8_SCHED;
            PG8_LDA(At, 1, 1); PG8_STAGE(PG8_SB(1, 0), b3, voffB); PG8_STAGE(PG8_SB(1, 1), b3 + hstepB, voffB); PG8_STAGE(PG8_SA(1, 0), a3, voffA);
            PG8_WAIT_V(8); PG8_WAIT_L(0); PG8_BAR; PG8_MMA(1, 0, At, B0); PG8_MMA(1, 1, At, B1); PG8_BAR; PG8_SCHED;
        }
        if constexpr (ALIGN_EPI) { if (wr == 0) PG8_BAR; }
        E(acc, cur, wr, wc, fr, fq);
        if (!has_next) break;
#pragma unroll
        for (int a = 0; a < 2; ++a)
#pragma unroll
            for (int b = 0; b < 2; ++b)
#pragma unroll
                for (int m = 0; m < 4; ++m)
#pragma unroll
                    for (int n = 0; n < 2; ++n) acc[a][b][m][n] = (f32x4){0.f, 0.f, 0.f, 0.f};
        cur = nxt; cA = nA; cB = nB; ++ui;
        if constexpr (ALIGN_EPI) { if (wr == 1) PG8_BAR; }
    }
    PG8_WAIT_V(0);
    if constexpr (!ALIGN_EPI) { if (wr == 0) PG8_BAR; }
    PG8_BAR;
#undef PG8_SA
#undef PG8_SB
#undef PG8_STAGE
#undef PG8_LDA
#undef PG8_LDB
#undef PG8_MMA
#undef PG8_WAIT_V
#undef PG8_WAIT_L
#undef PG8_BAR
#undef PG8_SCHED
}
}

struct Args { const float* in[23]; float* out; unsigned char* ws; int ph_lo, ph_hi; };

enum { W_GU1 = 0, W_D1, W_GU2, W_D2, W_IN, W_GA, W_GB, W_N, W_DIL, W_MIX, W_CK1, W_CV1, W_CK2, W_CV2, W_NMAT };
struct MatDesc { int K, Nd; size_t wsoff; };
__device__ __forceinline__ MatDesc mat_desc(int m) {
    switch (m) {
        case W_GU1: return {D, NGU, WS_WGU1};
        case W_D1: return {FF, D, WS_WD1};
        case W_GU2: return {D, NGU, WS_WGU2};
        case W_D2: return {FF, D, WS_WD2};
        case W_IN: return {D, PITCH, WS_WIN};
        case W_GA: return {D, D, WS_WGA};
        case W_GB: return {D, D, WS_WGB};
        case W_N: return {512, D, WS_WN};
        case W_DIL: return {256, D, WS_WDIL};
        case W_MIX: return {D, D, WS_WMIX};
        case W_CK1: return {2048, 256, WS_WCK1};
        case W_CV1: return {2048, 256, WS_WCV1};
        case W_CK2: return {256, 64, WS_SELM};
        default: return {256, 64, WS_SELM + 0x8000};
    }
}
__device__ __forceinline__ const float* mat_src(const Args& a, int m, int n, int& ldw) {
    switch (m) {
        case W_GU1: case W_GU2: { ldw = FF; const int c = (n >> 3) * 4 + (n & 3); const int gi = (m == W_GU1) ? 3 : 20; return ((n & 4) ? a.in[gi + 1] : a.in[gi]) + c; }
        case W_D1: ldw = D; return a.in[5] + n;
        case W_D2: ldw = D; return a.in[22] + n;
        case W_IN: { ldw = IN_DIM; int c; if (n < 1280) c = n; else if (n < 3584) c = n + 24; else if (n < 3608) c = n - 3584 + 1280; else return nullptr; return a.in[8] + c; }
        case W_GA: ldw = IN_DIM; return a.in[8] + 3608 + n;
        case W_GB: ldw = IN_DIM; return a.in[8] + 4632 + n;
        case W_N: ldw = D; return a.in[15] + n;
        case W_DIL: ldw = D; return a.in[16] + n;
        case W_MIX: ldw = D; return a.in[17] + n;
        case W_CK1: ldw = 256; return a.in[10] + n;
        case W_CV1: ldw = 256; return a.in[13] + n;
        case W_CK2: ldw = 64; return a.in[11] + n;
        default: ldw = 64; return a.in[14] + n;
    }
}
__device__ __forceinline__ void transpose_item(const Args& a, int m, int item, int lane) {
    const MatDesc md = mat_desc(m);
    const int nblk = md.Nd / 64, kb = item / nblk, nb = item % nblk, k0 = 64 * kb, n0 = 64 * nb;
    int ldw = 0; const float* src = mat_src(a, m, n0 + lane, ldw);
    float v[64];
    if (src) {
        const float* p = src + (size_t)k0 * ldw;
#pragma unroll
        for (int kk = 0; kk < 64; ++kk) v[kk] = p[(size_t)kk * ldw];
    } else {
#pragma unroll
        for (int kk = 0; kk < 64; ++kk) v[kk] = 0.f;
    }
    u32x4* dst = (u32x4*)((bf16_t*)(a.ws + md.wsoff) + (size_t)(n0 + lane) * md.K + k0);
#pragma unroll
    for (int c = 0; c < 8; ++c) { u32x4 o; o.x = pk2(v[8 * c], v[8 * c + 1]); o.y = pk2(v[8 * c + 2], v[8 * c + 3]); o.z = pk2(v[8 * c + 4], v[8 * c + 5]); o.w = pk2(v[8 * c + 6], v[8 * c + 7]); dst[c] = o; }
}

template <bool XIN16, bool XO16>
__device__ __forceinline__ void row_pass(const void* xin_, const bf16_t* y, float scale, const float* gpost, void* xo_, const float* gnext, bf16_t* hout, int gw, int ngw, int lane) {
    const float* xin = (const float*)xin_; const bf16_t* xin16 = (const bf16_t*)xin_; float* xo = (float*)xo_; bf16_t* xo16 = (bf16_t*)xo_;
    f32x4 nv[4]; u32x2 ny[4];
#pragma unroll
    for (int j = 0; j < 4; ++j) { nv[j] = (f32x4){0.f, 0.f, 0.f, 0.f}; ny[j] = (u32x2){0u, 0u}; }
    if (gw < T) {
        if (XIN16) { const u32x2* xr = (const u32x2*)(xin16 + (size_t)gw * D) + lane;
#pragma unroll
            for (int j = 0; j < 4; ++j) { const u32x2 w = xr[64 * j]; nv[j] = (f32x4){bflo(w.x), bfhi(w.x), bflo(w.y), bfhi(w.y)}; } }
        else { const f32x4* xr = (const f32x4*)(xin + (size_t)gw * D) + lane;
#pragma unroll
            for (int j = 0; j < 4; ++j) nv[j] = xr[64 * j]; }
        if (y) { const u32x2* yr = (const u32x2*)(y + (size_t)gw * D) + lane;
#pragma unroll
            for (int j = 0; j < 4; ++j) ny[j] = yr[64 * j]; }
    }
    for (int m = gw; m < T; m += ngw) {
        f32x4 v[4]; u32x2 yw[4];
#pragma unroll
        for (int j = 0; j < 4; ++j) { v[j] = nv[j]; yw[j] = ny[j]; }
        const int mn = m + ngw;
        if (mn < T) {
            if (XIN16) { const u32x2* xr = (const u32x2*)(xin16 + (size_t)mn * D) + lane;
#pragma unroll
                for (int j = 0; j < 4; ++j) { const u32x2 w = xr[64 * j]; nv[j] = (f32x4){bflo(w.x), bfhi(w.x), bflo(w.y), bfhi(w.y)}; } }
            else { const f32x4* xr = (const f32x4*)(xin + (size_t)mn * D) + lane;
#pragma unroll
                for (int j = 0; j < 4; ++j) nv[j] = xr[64 * j]; }
            if (y) { const u32x2* yr = (const u32x2*)(y + (size_t)mn * D) + lane;
#pragma unroll
                for (int j = 0; j < 4; ++j) ny[j] = yr[64 * j]; }
        }
        if (y) {
            f32x4 yv[4]; float s = 0.f;
#pragma unroll
            for (int j = 0; j < 4; ++j) { const u32x2 w = yw[j]; yv[j] = (f32x4){bflo(w.x), bfhi(w.x), bflo(w.y), bfhi(w.y)}; s += (yv[j].x * yv[j].x + yv[j].y * yv[j].y) + (yv[j].z * yv[j].z + yv[j].w * yv[j].w); }
            const float rs = rsqrtf(wave_sum(s) * (1.f / D) + RMS_EPS) * scale;
#pragma unroll
            for (int j = 0; j < 4; ++j) { const f32x4 g = ((const f32x4*)gpost)[lane + 64 * j]; v[j] = v[j] + yv[j] * rs * g; }
            if (XO16) { u32x2* xw = (u32x2*)(xo16 + (size_t)m * D) + lane;
#pragma unroll
                for (int j = 0; j < 4; ++j) { u32x2 w; w.x = pk2(v[j].x, v[j].y); w.y = pk2(v[j].z, v[j].w); xw[64 * j] = w; } }
            else { f32x4* xw = (f32x4*)(xo + (size_t)m * D) + lane;
#pragma unroll
                for (int j = 0; j < 4; ++j) xw[64 * j] = v[j]; }
        }
        if (hout) {
            float s = 0.f;
#pragma unroll
            for (int j = 0; j < 4; ++j) s += (v[j].x * v[j].x + v[j].y * v[j].y) + (v[j].z * v[j].z + v[j].w * v[j].w);
            const float rs = rsqrtf(wave_sum(s) * (1.f / D) + RMS_EPS);
            u32x2* hw = (u32x2*)(hout + (size_t)m * D) + lane;
#pragma unroll
            for (int j = 0; j < 4; ++j) { const f32x4 g = ((const f32x4*)gnext)[lane + 64 * j]; const f32x4 o = v[j] * rs * g; u32x2 w; w.x = pk2(o.x, o.y); w.y = pk2(o.z, o.w); hw[64 * j] = w; }
        }
    }
}

constexpr int KP = 144, VP = 192;
constexpr int KST = 64 * KP, VST = 64 * VP;
constexpr int ATT_K0 = 0, ATT_V0 = 2 * KST;
constexpr int ATT_MISC = ATT_V0 + 2 * VST;
constexpr int ATT_SELL = ATT_MISC + 128;
constexpr int ATT_IMP = 44032;
constexpr int ATT_ACC = 110592;
enum { AT_BAND = 0, AT_CMP = 1, AT_SEL = 2 };
enum { MD_ONLINE = 0, MD_STATS = 1, MD_NORM = 2 };

__device__ __forceinline__ s16x4 tr16(const LAS unsigned char* p) {
    return __builtin_bit_cast(s16x4, __builtin_amdgcn_ds_read_tr16_b64_v4i16((LAS s16x4*)p));
}
__device__ __forceinline__ float xhalf_max(float m) {
    auto rr = __builtin_amdgcn_permlane32_swap(__builtin_bit_cast(unsigned, m), __builtin_bit_cast(unsigned, m), false, false);
    return fmaxf(__builtin_bit_cast(float, rr[0]), __builtin_bit_cast(float, rr[1]));
}

struct AttnWave {
    bf16x8 qf[4];
    f32x16 o[2];
    float kb[16];
    float m, l;
    int iq, i0w;
    int jlo, jhi;
    float c1, sb;
    int j0;
    int max_back;
    unsigned long long mysel;
    float mfin, invl;
    bool started;
};

template <int TYPE, int MODE>
__device__ __forceinline__ void attn_stage(AttnWave& W, const LAS unsigned char* Kl, const LAS unsigned char* Vl, int cur, int lane, LAS float* imp  , bool wave_skip_sel) {
    const int r32 = lane & 31, h = lane >> 5;
    const int jt = 64 * cur;
    {
        bool skip = (jt + 63 < W.jlo) || (jt > W.jhi);
        if (TYPE == AT_SEL) skip = skip || wave_skip_sel;
        if (TYPE == AT_CMP && MODE == MD_NORM) skip = false;
        if (skip) return;
    }
    bool lane_on = true;
    if (TYPE == AT_SEL) lane_on = ((W.mysel >> cur) & 1ull) != 0ull;
    const float ref = (MODE == MD_NORM) ? W.mfin : W.m;
    float base0 = W.sb * (float)(jt - W.j0) - ref;
    if (TYPE == AT_SEL) base0 = lane_on ? base0 : -INFINITY;
    const float base1 = base0 + 32.0f * W.sb;
    f32x16 s0, s1;
#pragma unroll
    for (int r = 0; r < 16; ++r) { s0[r] = W.kb[r] + base0; s1[r] = W.kb[r] + base1; }
    const LAS unsigned char* kp = Kl + r32 * KP + h * 16;
    bf16x8 kf0[4], kf1[4];
#pragma unroll
    for (int ds = 0; ds < 4; ++ds) { kf0[ds] = *(const LAS bf16x8*)(kp + ds * 32); kf1[ds] = *(const LAS bf16x8*)(kp + 32 * KP + ds * 32); }
    __builtin_amdgcn_sched_barrier(0);
#pragma unroll
    for (int ds = 0; ds < 4; ++ds) {
        s0 = __builtin_amdgcn_mfma_f32_32x32x16_bf16(kf0[ds], W.qf[ds], s0, 0, 0, 0);
        s1 = __builtin_amdgcn_mfma_f32_32x32x16_bf16(kf1[ds], W.qf[ds], s1, 0, 0, 0);
    }
    const LAS unsigned char* vp = Vl + (4 * h + ((lane & 15) >> 2)) * VP + (16 * ((lane >> 4) & 1) + 4 * (lane & 3)) * 2;
    s16x4 vlo[4][2], vhi[4][2];
    if (MODE != MD_STATS) {
#pragma unroll
        for (int s4 = 0; s4 < 4; ++s4)
#pragma unroll
            for (int blk = 0; blk < 2; ++blk) { vlo[s4][blk] = tr16(vp + (16 * s4) * VP + blk * 64); vhi[s4][blk] = tr16(vp + (16 * s4 + 8) * VP + blk * 64); }
    }
    __builtin_amdgcn_sched_barrier(0);
    float x0[16], x1[16];
#pragma unroll
    for (int r = 0; r < 16; ++r) { x0[r] = s0[r]; x1[r] = s1[r]; }
    if (TYPE == AT_BAND) {
        const bool interior = (jt + 63 <= W.i0w) && (W.i0w + 31 - jt <= W.max_back);
        if (!interior) {
            const int d = W.iq - jt - 4 * h;
#pragma unroll
            for (int r = 0; r < 16; ++r) { const int cr = (r & 3) + 8 * (r >> 2);
                x0[r] = ((unsigned)(d - cr) <= (unsigned)W.max_back) ? x0[r] : -INFINITY;
                x1[r] = ((unsigned)(d - 32 - cr) <= (unsigned)W.max_back) ? x1[r] : -INFINITY; }
        }
    } else if (TYPE == AT_CMP) {
        int lim = (W.iq - 31) >> 4; lim = lim > NCMP - 1 ? NCMP - 1 : lim; lim -= jt + 4 * h;
#pragma unroll
        for (int r = 0; r < 16; ++r) { const int cr = (r & 3) + 8 * (r >> 2); x0[r] = (cr <= lim) ? x0[r] : -INFINITY; x1[r] = (cr + 32 <= lim) ? x1[r] : -INFINITY; }
    } else {
        if (jt + 63 > W.i0w) {
            const int d = W.iq - jt - 4 * h;
#pragma unroll
            for (int r = 0; r < 16; ++r) { const int cr = (r & 3) + 8 * (r >> 2); x0[r] = (cr <= d) ? x0[r] : -INFINITY; x1[r] = (cr + 32 <= d) ? x1[r] : -INFINITY; }
        }
    }
    float p0[16], p1[16];
    if (MODE != MD_NORM) {
        float ma = fmaxf(fmaxf(x0[0], x0[1]), fmaxf(x0[2], x0[3])), mb = fmaxf(fmaxf(x1[0], x1[1]), fmaxf(x1[2], x1[3]));
#pragma unroll
        for (int r = 4; r < 16; r += 4) { ma = fmaxf(ma, fmaxf(fmaxf(x0[r], x0[r + 1]), fmaxf(x0[r + 2], x0[r + 3]))); mb = fmaxf(mb, fmaxf(fmaxf(x1[r], x1[r + 1]), fmaxf(x1[r + 2], x1[r + 3]))); }
        const float gmx = xhalf_max(fmaxf(ma, mb));
        const bool need = W.started ? (gmx > 60.0f) : (gmx > -INFINITY);
        if (__builtin_amdgcn_ballot_w64(need) != 0ull) {
            const float delta = need ? gmx : 0.f;
            const float f = W.started ? __builtin_amdgcn_exp2f(-delta) : 1.0f;
            W.m += delta; W.started = W.started || need;
            W.l *= f;
#pragma unroll
            for (int r = 0; r < 16; ++r) { x0[r] -= delta; x1[r] -= delta; }
            if (MODE == MD_ONLINE) {
#pragma unroll
                for (int r = 0; r < 16; ++r) { W.o[0][r] *= f; W.o[1][r] *= f; }
            }
        }
        float lsa = 0.f, lsb = 0.f;
#pragma unroll
        for (int r = 0; r < 16; ++r) { p0[r] = __builtin_amdgcn_exp2f(x0[r]); lsa += p0[r]; p1[r] = __builtin_amdgcn_exp2f(x1[r]); lsb += p1[r]; }
        W.l += lsa + lsb;
    } else {
#pragma unroll
        for (int r = 0; r < 16; ++r) { p0[r] = __builtin_amdgcn_exp2f(x0[r]) * W.invl; p1[r] = __builtin_amdgcn_exp2f(x1[r]) * W.invl; }
    }
    if (TYPE == AT_CMP && MODE == MD_NORM) {
#pragma unroll
        for (int hf = 0; hf < 2; ++hf)
#pragma unroll
            for (int i = 0; i < 4; ++i) {
                const float q0 = hf ? p1[4 * i] : p0[4 * i], q1 = hf ? p1[4 * i + 1] : p0[4 * i + 1], q2 = hf ? p1[4 * i + 2] : p0[4 * i + 2], q3 = hf ? p1[4 * i + 3] : p0[4 * i + 3];
                const float Bv = 0.5f * q3;
                const float A = (q0 + q1) + (q2 + Bv);
                const int u = 8 * (2 * cur + hf) + 2 * i + h;
                imp[u] += A;
                asm volatile("" ::: "memory");
                imp[u + 1] += Bv;
                asm volatile("" ::: "memory");
            }
    }
    if (MODE != MD_STATS) {
        bf16x8 pb[4];
#pragma unroll
        for (int s2 = 0; s2 < 2; ++s2) {
            u32x4 w; w.x = pk2(p0[8 * s2 + 0], p0[8 * s2 + 1]); w.y = pk2(p0[8 * s2 + 2], p0[8 * s2 + 3]); w.z = pk2(p0[8 * s2 + 4], p0[8 * s2 + 5]); w.w = pk2(p0[8 * s2 + 6], p0[8 * s2 + 7]);
            pb[s2] = __builtin_bit_cast(bf16x8, w);
            u32x4 z; z.x = pk2(p1[8 * s2 + 0], p1[8 * s2 + 1]); z.y = pk2(p1[8 * s2 + 2], p1[8 * s2 + 3]); z.z = pk2(p1[8 * s2 + 4], p1[8 * s2 + 5]); z.w = pk2(p1[8 * s2 + 6], p1[8 * s2 + 7]);
            pb[2 + s2] = __builtin_bit_cast(bf16x8, z);
        }
#pragma unroll
        for (int s4 = 0; s4 < 4; ++s4) {
#pragma unroll
            for (int blk = 0; blk < 2; ++blk) {
                const s16x4 lo = vlo[s4][blk], hi = vhi[s4][blk];
                const bf16x8 vf = (bf16x8){lo[0], lo[1], lo[2], lo[3], hi[0], hi[1], hi[2], hi[3]};
                W.o[blk] = __builtin_amdgcn_mfma_f32_32x32x16_bf16(vf, pb[s4], W.o[blk], 0, 0, 0);
            }
        }
    }
}

struct AttnUnitDesc {
    const bf16_t* K; const bf16_t* V; long kvstride; int jclamp;
    unsigned long long stmask;
};

template <int TYPE, int MODE, int NH = 1>
__device__ __forceinline__ void attn_run(AttnWave& W, const AttnUnitDesc& U, LAS unsigned char* lds, int tid, int lane, LAS float* imp, unsigned long long wavemask, int hsel = 0, size_t hstride = 0) {
    const int srow = tid >> 3, sch = tid & 7;
    constexpr int V0 = 2 * NH * KST;
    unsigned long long rem = U.stmask;
    int cur = 63 - __builtin_clzll(rem); rem &= ~(1ull << cur);
    u32x4 kreg[NH], vreg[NH];
    { int j = 64 * cur + srow; j = j > U.jclamp ? U.jclamp : j; const size_t off = (size_t)j * U.kvstride + sch * 8;
#pragma unroll
      for (int hs = 0; hs < NH; ++hs) { kreg[hs] = *(const u32x4*)(U.K + off + hs * hstride); vreg[hs] = *(const u32x4*)(U.V + off + hs * hstride); } }
    int buf = 0;
#pragma unroll
    for (int hs = 0; hs < NH; ++hs) { *(LAS u32x4*)(lds + hs * KST + srow * KP + sch * 16) = kreg[hs]; *(LAS u32x4*)(lds + V0 + hs * VST + srow * VP + sch * 16) = vreg[hs]; }
    __syncthreads();
    for (;;) {
        int nxt = -1;
        if (rem) { nxt = 63 - __builtin_clzll(rem); rem &= ~(1ull << nxt);
            int j = 64 * nxt + srow; j = j > U.jclamp ? U.jclamp : j; const size_t off = (size_t)j * U.kvstride + sch * 8;
#pragma unroll
            for (int hs = 0; hs < NH; ++hs) { kreg[hs] = *(const u32x4*)(U.K + off + hs * hstride); vreg[hs] = *(const u32x4*)(U.V + off + hs * hstride); } }
        const bool wskip = (TYPE == AT_SEL) ? (((wavemask >> cur) & 1ull) == 0ull) : false;
        attn_stage<TYPE, MODE>(W, lds + (buf * NH + hsel) * KST, lds + V0 + (buf * NH + hsel) * VST, cur, lane, imp, wskip);
        if (nxt < 0) break;
#pragma unroll
        for (int hs = 0; hs < NH; ++hs) { *(LAS u32x4*)(lds + ((buf ^ 1) * NH + hs) * KST + srow * KP + sch * 16) = kreg[hs]; *(LAS u32x4*)(lds + V0 + ((buf ^ 1) * NH + hs) * VST + srow * VP + sch * 16) = vreg[hs]; }
        __syncthreads();
        buf ^= 1; cur = nxt;
    }
    __syncthreads();
}

__device__ __forceinline__ void attn_init(AttnWave& W, int lane, int i0w, float slope_l2, int dstep) {
#pragma unroll
    for (int r = 0; r < 16; ++r) { W.o[0][r] = 0.f; W.o[1][r] = 0.f; }
    W.m = 0.f; W.l = 0.f; W.mysel = 0ull; W.mfin = 0.f; W.invl = 0.f; W.max_back = 0; W.started = false;
    W.i0w = i0w; W.iq = i0w + (lane & 31); W.c1 = 0.125f * LOG2E; W.sb = slope_l2 * (float)dstep;
#pragma unroll
    for (int r = 0; r < 16; ++r) W.kb[r] = W.sb * (float)((r & 3) + 8 * (r >> 2) + 4 * (lane >> 5));
}
__device__ __forceinline__ void load_q(AttnWave& W, const bf16_t* Qw, long qstride, int lane) {
    const int r32 = lane & 31, h = lane >> 5;
#pragma unroll
    for (int ds = 0; ds < 4; ++ds) {
        const u32x4 w = *(const u32x4*)(Qw + (size_t)r32 * qstride + 16 * ds + 8 * h); const float c = W.c1;
        u32x4 o; o.x = pk2(bflo(w.x) * c, bfhi(w.x) * c); o.y = pk2(bflo(w.y) * c, bfhi(w.y) * c); o.z = pk2(bflo(w.z) * c, bfhi(w.z) * c); o.w = pk2(bflo(w.w) * c, bfhi(w.w) * c);
        W.qf[ds] = __builtin_bit_cast(bf16x8, o);
    }
}

__device__ __forceinline__ float nsa_slope(int head) { return exp2f(-(float)(head + 1)); }
__device__ __forceinline__ void gqa_decode(int u, int& b, int& g, int& qb) {
    const int low6 = u & 63, hi4 = u >> 6, k = hi4 >> 2; b = hi4 >> 1; g = hi4 & 1;
    const int base = (low6 + 32 * (k >> 1)) & 63; qb = (k & 1) ? 63 - base : base;
}

__device__ __forceinline__ void unit_dilated(const Args& a, int id, LAS unsigned char* lds, int tid, int wid, int lane) {
    const int grp = id >> 9, rem = id & 511, b = rem >> 6, hp = (rem >> 5) & 1, sub = rem & 31;
    const int dil = grp == 0 ? 1 : (grp == 1 ? 4 : 16);
    const int r = sub % dil, ublk = sub / dil;
    const int hsel = wid >> 2, hi = 2 * hp + hsel;
    const bf16_t* slab0 = (const bf16_t*)(a.ws + WS_BIG) + DILS_OFF + ((size_t)(4 * grp + 2 * hp) * T + (size_t)b * SEQ + (size_t)r * (SEQ / dil)) * 64;
    const int i0w = 128 * ublk + 32 * (wid & 3);
    const float slope = exp2f(-8.0f * (float)(4 * grp + hi + 1) / 12.0f);
    AttnWave W; attn_init(W, lane, i0w, slope * LOG2E, dil);
    load_q(W, slab0 + (size_t)hsel * T * 64 + (size_t)i0w * 64, 64, lane);
    W.jlo = i0w - 128; W.jhi = i0w + 31; W.max_back = 128;
    const int slo = ublk > 0 ? 2 * ublk - 2 : 0, shi = 2 * ublk + 1; W.j0 = 64 * shi;
    AttnUnitDesc U; U.K = slab0 + (size_t)12 * T * 64; U.V = slab0 + (size_t)24 * T * 64; U.kvstride = 64; U.jclamp = SEQ / dil - 1;
    U.stmask = ((shi == 63) ? ~0ull : ((2ull << shi) - 1ull)) & ~((1ull << slo) - 1ull);
    attn_run<AT_BAND, MD_ONLINE, 2>(W, U, lds, tid, lane, nullptr, 0ull, hsel, (size_t)T * 64);
    const float lt = W.l + __shfl_xor(W.l, 32); const float inv = 1.0f / fmaxf(lt, 1e-30f);
    const size_t tok = (size_t)b * SEQ + (size_t)dil * W.iq + r;
    bf16_t* orow = (bf16_t*)(a.ws + WS_Y) + ((size_t)grp * T + tok) * 256 + hi * 64;
    const int h = lane >> 5;
#pragma unroll
    for (int blk = 0; blk < 2; ++blk)
#pragma unroll
        for (int i = 0; i < 4; ++i) { u32x2 w; w.x = pk2(W.o[blk][4 * i] * inv, W.o[blk][4 * i + 1] * inv); w.y = pk2(W.o[blk][4 * i + 2] * inv, W.o[blk][4 * i + 3] * inv);
            *(u32x2*)(orow + 32 * blk + 8 * i + 4 * h) = w; }
    if (h == 0) ((float*)(a.ws + WS_LSE))[((size_t)grp * T + tok) * 4 + hi] = (W.m + __log2f(lt) - W.sb * (float)(W.iq - W.j0)) * 0.6931471805599453f;
}

__device__ __forceinline__ void unit_nsa(const Args& a, int b, int g, int qb, LAS unsigned char* lds, int tid, int wid, int lane) {
    const bf16_t* big = (const bf16_t*)(a.ws + WS_BIG);
    const bf16_t* kvn = big + KVN_OFF + (size_t)b * SEQ * 64;
    const int hl = wid >> 1, head = g * 4 + hl, i0w = 64 * qb + 32 * (wid & 1);
    const float sl2 = nsa_slope(head) * LOG2E;
    LAS float* IMP = (LAS float*)(lds + ATT_IMP);
    for (int i = tid; i < 4 * 64 * 65; i += 512) IMP[i] = 0.f;
    const size_t tok = (size_t)b * SEQ + i0w + (lane & 31);
    const bf16_t* gp = big + tok * QGP + 512 + head * 3;
    const float g0 = sigmoidf_(bflo((unsigned)gp[0])), g1 = sigmoidf_(bflo((unsigned)gp[1])), g2 = sigmoidf_(bflo((unsigned)gp[2]));
    AttnWave W; AttnUnitDesc U;
    LAS u32x2* accl = (LAS u32x2*)(lds + ATT_ACC + wid * 4096) + lane;
    attn_init(W, lane, i0w, sl2, 1);
    load_q(W, big + ((size_t)b * SEQ + i0w) * QGP + head * 64, QGP, lane);
    {
        W.jlo = i0w - 511; W.jhi = i0w + 31; W.max_back = 511;
        const int slo = qb >= 8 ? qb - 8 : 0; W.j0 = 64 * qb;
        U.K = kvn + (size_t)(8 + g) * T * 64; U.V = kvn + (size_t)(10 + g) * T * 64; U.kvstride = 64; U.jclamp = SEQ - 1;
        U.stmask = ((qb == 63) ? ~0ull : ((2ull << qb) - 1ull)) & ~((1ull << slo) - 1ull);
        attn_run<AT_BAND, MD_ONLINE>(W, U, lds, tid, lane, nullptr, 0ull);
        const float lt = W.l + __shfl_xor(W.l, 32); const float sc = g2 / fmaxf(lt, 1e-30f);
#pragma unroll
        for (int blk = 0; blk < 2; ++blk)
#pragma unroll
            for (int i = 0; i < 4; ++i) { u32x2 w; w.x = pk2(W.o[blk][4 * i] * sc, W.o[blk][4 * i + 1] * sc); w.y = pk2(W.o[blk][4 * i + 2] * sc, W.o[blk][4 * i + 3] * sc); accl[(blk * 4 + i) * 64] = w; }
    }
    attn_init(W, lane, i0w, sl2, 16);
    {
        W.jlo = 0; W.jhi = i0w >> 4;
        const int cmax = 4 * qb + 2, shi = cmax >> 6; W.j0 = 64 * shi;
        U.K = (const bf16_t*)(a.ws + WS_KC) + (size_t)(b * 2 + g) * 256 * 64; U.V = (const bf16_t*)(a.ws + WS_VC) + (size_t)(b * 2 + g) * 256 * 64; U.kvstride = 64; U.jclamp = NCMP - 1;
        U.stmask = (2ull << shi) - 1ull;
        LAS float* impw = IMP + ((size_t)hl * 64 + 32 * (wid & 1) + (lane & 31)) * 65;
        attn_run<AT_CMP, MD_STATS>(W, U, lds, tid, lane, impw, 0ull);
        const float lt = W.l + __shfl_xor(W.l, 32);
        W.mfin = W.m; W.invl = 1.0f / fmaxf(lt, 1e-30f);
        attn_run<AT_CMP, MD_NORM>(W, U, lds, tid, lane, impw, 0ull);
#pragma unroll
        for (int blk = 0; blk < 2; ++blk)
#pragma unroll
            for (int i = 0; i < 4; ++i) { const u32x2 p = accl[(blk * 4 + i) * 64]; u32x2 w;
                w.x = pk2(bflo(p.x) + W.o[blk][4 * i] * g0, bfhi(p.x) + W.o[blk][4 * i + 1] * g0); w.y = pk2(bflo(p.y) + W.o[blk][4 * i + 2] * g0, bfhi(p.y) + W.o[blk][4 * i + 3] * g0); accl[(blk * 4 + i) * 64] = w; }
    }
    LAS unsigned long long* SELL = (LAS unsigned long long*)(lds + ATT_SELL);
    for (int qq = 8 * wid; qq < 8 * wid + 8; ++qq) {
        float val = ((IMP[(0 * 64 + qq) * 65 + lane] + IMP[(1 * 64 + qq) * 65 + lane]) + IMP[(2 * 64 + qq) * 65 + lane]) + IMP[(3 * 64 + qq) * 65 + lane];
        const int own = qb, j = lane;
        const bool forced = (j == 0) || (j == own) || (j == own - 1);
        const bool valid = j <= own;
        val = forced ? INFINITY : (valid ? val : -INFINITY);
        const unsigned key = (val == -INFINITY) ? 0u : (__builtin_bit_cast(unsigned, val) + 1u);
        unsigned Tk = 0u;
#pragma unroll
        for (int bit = 30; bit >= 0; --bit) { const unsigned c = Tk | (1u << bit); if (__builtin_popcountll(__ballot(key >= c)) >= 16) Tk = c; }
        unsigned long long msk = __ballot(key > Tk), eq = __ballot(key == Tk);
        for (int need = 16 - __builtin_popcountll(msk); need > 0; --need) { const unsigned long long low = eq & (0ull - eq); msk |= low; eq ^= low; }
        if (lane == 0) SELL[qq] = msk;
    }
    __syncthreads();
    attn_init(W, lane, i0w, sl2, 1);
    {
        W.jlo = 0; W.jhi = i0w + 31; W.j0 = 64 * qb;
        W.mysel = SELL[32 * (wid & 1) + (lane & 31)];
        unsigned lo = (unsigned)W.mysel, hi = (unsigned)(W.mysel >> 32);
#pragma unroll
        for (int o = 1; o < 64; o <<= 1) { lo |= __shfl_xor(lo, o); hi |= __shfl_xor(hi, o); }
        const unsigned long long wm = ((unsigned long long)hi << 32) | lo;
        unsigned long long um = 0ull;
#pragma unroll
        for (int q = 0; q < 64; ++q) um |= SELL[q];
        const unsigned long long causal = (qb == 63) ? ~0ull : ((2ull << qb) - 1ull);
        um &= causal; um |= 1ull;
        U.K = kvn + (size_t)(4 + g) * T * 64; U.V = kvn + (size_t)(6 + g) * T * 64; U.kvstride = 64; U.jclamp = SEQ - 1; U.stmask = um;
        attn_run<AT_SEL, MD_ONLINE>(W, U, lds, tid, lane, nullptr, wm);
        const float lt = W.l + __shfl_xor(W.l, 32); const float sc = g1 / fmaxf(lt, 1e-30f);
        bf16_t* orow = (bf16_t*)(a.ws + WS_ONSA) + tok * 512 + head * 64;
        const int h = lane >> 5;
#pragma unroll
        for (int blk = 0; blk < 2; ++blk)
#pragma unroll
            for (int i = 0; i < 4; ++i) { const u32x2 p = accl[(blk * 4 + i) * 64]; u32x2 w;
                w.x = pk2(bflo(p.x) + W.o[blk][4 * i] * sc, bfhi(p.x) + W.o[blk][4 * i + 1] * sc); w.y = pk2(bflo(p.y) + W.o[blk][4 * i + 2] * sc, bfhi(p.y) + W.o[blk][4 * i + 3] * sc);
                *(u32x2*)(orow + 32 * blk + 8 * i + 4 * h) = w; }
    }
}

constexpr int LDS_BIAS = 131072;
__device__ __forceinline__ void unit_compress_full(const Args& a, int id, LAS unsigned char* lds, int tid_in) {
    const int which = id >> 4, b = (id >> 1) & 7, g = id & 1;
    LAS float* bias = (LAS float*)(lds + LDS_BIAS);
    int tid = tid_in; asm volatile("" : "+v"(tid));
    if (tid < 256) bias[tid] = ((const float*)(a.ws + WS_BIASP + 0x10000))[which * 256 + tid];
    __syncthreads();
    bf16_t* CH = (bf16_t*)(a.ws + WS_CH) + (size_t)id * 65536;
    {
        int K = 2048; asm volatile("" : "+s"(K));
        pg8::Gemm gm{(const bf16_t*)(a.ws + WS_BIG), (const bf16_t*)(a.ws + (which ? WS_WCV1 : WS_WCK1)), K, 16 * 64, 128, 2048};
        int one = 1; asm volatile("" : "+s"(one));
        pg8::OneUnit S{(KVN_OFF + ((size_t)(which * 2 + g) * T + (size_t)b * SEQ) * 64) * 2, one};
        pg8::Epi<pg8::EP_STORE> E{CH, 256, nullptr, nullptr, nullptr};
        pg8::gemm_phase<pg8::Epi<pg8::EP_STORE>, pg8::OneUnit, true>(lds, gm, S, E);
    }
    __threadfence();
    __syncthreads();
    tid = tid_in; asm volatile("" : "+v"(tid));
    {
        const int lane = tid & 63, wv = tid >> 6, fr = lane & 15, fq = lane >> 4;
        const bf16_t* w2t = (const bf16_t*)(a.ws + WS_SELM + (which ? 0x8000 : 0));
        f32x4 acc[2][4];
#pragma unroll
        for (int rt = 0; rt < 2; ++rt)
#pragma unroll
            for (int ct = 0; ct < 4; ++ct) acc[rt][ct] = (f32x4){0.f, 0.f, 0.f, 0.f};
        for (int ks = 0; ks < 8; ++ks) {
            const int k0 = 32 * ks + 8 * fq;
            const f32x4 b0 = *(const LAS f32x4*)(bias + k0), b1 = *(const LAS f32x4*)(bias + k0 + 4);
            bf16x8 af[2], bfr[4];
#pragma unroll
            for (int rt = 0; rt < 2; ++rt) {
                const u32x4 hv = *(const u32x4*)(CH + (size_t)(32 * wv + 16 * rt + fr) * 256 + k0);
                float hx[8] = {bflo(hv.x) + b0.x, bfhi(hv.x) + b0.y, bflo(hv.y) + b0.z, bfhi(hv.y) + b0.w, bflo(hv.z) + b1.x, bfhi(hv.z) + b1.y, bflo(hv.w) + b1.z, bfhi(hv.w) + b1.w};
#pragma unroll
                for (int e = 0; e < 8; ++e) { const float x = hx[e]; const float z = 0.7978845608028654f * (x + 0.044715f * x * x * x); hx[e] = x * sigmoidf_(2.0f * z); }
                u32x4 w; w.x = pk2(hx[0], hx[1]); w.y = pk2(hx[2], hx[3]); w.z = pk2(hx[4], hx[5]); w.w = pk2(hx[6], hx[7]);
                af[rt] = __builtin_bit_cast(bf16x8, w);
            }
#pragma unroll
            for (int ct = 0; ct < 4; ++ct) bfr[ct] = *(const bf16x8*)(w2t + (size_t)(16 * ct + fr) * 256 + k0);
#pragma unroll
            for (int rt = 0; rt < 2; ++rt)
#pragma unroll
                for (int ct = 0; ct < 4; ++ct) acc[rt][ct] = __builtin_amdgcn_mfma_f32_16x16x32_bf16(bfr[ct], af[rt], acc[rt][ct], 0, 0, 0);
        }
        bf16_t* obase = (bf16_t*)(a.ws + (which ? WS_VC : WS_KC)) + (size_t)(b * 2 + g) * 256 * 64;
#pragma unroll
        for (int rt = 0; rt < 2; ++rt) { const int c = 32 * wv + 16 * rt + fr;
            if (c < NCMP) {
#pragma unroll
                for (int ct = 0; ct < 4; ++ct) { u32x2 w; w.x = pk2(acc[rt][ct][0], acc[rt][ct][1]); w.y = pk2(acc[rt][ct][2], acc[rt][ct][3]); *(u32x2*)(obase + (size_t)c * 64 + 16 * ct + 4 * fq) = w; }
            } }
    }
    __syncthreads();
}

__device__ __forceinline__ void dil_combine(const Args& a, int gtid, int ngt) {
    const bf16_t* odg = (const bf16_t*)(a.ws + WS_Y); const float* lse = (const float*)(a.ws + WS_LSE); bf16_t* od = (bf16_t*)(a.ws + WS_ODIL);
    for (size_t it = gtid; it < (size_t)T * 32; it += ngt) {
        const size_t tok = it >> 5; const int c8 = (int)(it & 31), hi = c8 >> 3;
        const float l0 = lse[tok * 4 + hi], l1 = lse[((size_t)T + tok) * 4 + hi], l2 = lse[((size_t)2 * T + tok) * 4 + hi];
        const float mx = fmaxf(l0, fmaxf(l1, l2));
        float w0 = __expf(l0 - mx), w1 = __expf(l1 - mx), w2 = __expf(l2 - mx); const float inv = 1.0f / (w0 + w1 + w2); w0 *= inv; w1 *= inv; w2 *= inv;
        const u32x4 p0 = *(const u32x4*)(odg + tok * 256 + c8 * 8), p1 = *(const u32x4*)(odg + ((size_t)T + tok) * 256 + c8 * 8), p2 = *(const u32x4*)(odg + ((size_t)2 * T + tok) * 256 + c8 * 8);
        u32x4 o;
        o.x = pk2(w0 * bflo(p0.x) + w1 * bflo(p1.x) + w2 * bflo(p2.x), w0 * bfhi(p0.x) + w1 * bfhi(p1.x) + w2 * bfhi(p2.x));
        o.y = pk2(w0 * bflo(p0.y) + w1 * bflo(p1.y) + w2 * bflo(p2.y), w0 * bfhi(p0.y) + w1 * bfhi(p1.y) + w2 * bfhi(p2.y));
        o.z = pk2(w0 * bflo(p0.z) + w1 * bflo(p1.z) + w2 * bflo(p2.z), w0 * bfhi(p0.z) + w1 * bfhi(p1.z) + w2 * bfhi(p2.z));
        o.w = pk2(w0 * bflo(p0.w) + w1 * bflo(p1.w) + w2 * bflo(p2.w), w0 * bfhi(p0.w) + w1 * bfhi(p1.w) + w2 * bfhi(p2.w));
        *(u32x4*)(od + tok * 256 + c8 * 8) = o;
    }
}


#define XB_TMO      128
#define XB_XCNT(j)  (256  + 64 * (j))
#define XB_XSUB(j)  (1280 + 64 * (j))
#define XB_XGEN(j)  (2304 + 64 * (j))
#define XB_TOP      3328
#define XB_TOPGEN   3392
#define XCD_BAR_WORDS 3456
#define XB_SPIN_CAP (1u << 18)
__device__ __forceinline__ unsigned xb_ld(unsigned* p)              { return __hip_atomic_load(p, __ATOMIC_RELAXED, __HIP_MEMORY_SCOPE_AGENT); }
__device__ __forceinline__ unsigned xb_add(unsigned* p, unsigned v) { return __hip_atomic_fetch_add(p, v, __ATOMIC_RELAXED, __HIP_MEMORY_SCOPE_AGENT); }
__device__ __forceinline__ unsigned xb_xcc_id() { return (unsigned)__builtin_amdgcn_s_getreg((3 << 11) | 20) & 0xFu; }
#define XB_SPIN(cond, bar) do { unsigned _sp = 0; while (cond) { __builtin_amdgcn_s_sleep(1); \
    if ((++_sp & 255u) == 0u) { if (xb_ld(&(bar)[XB_TMO])) break; if (_sp > XB_SPIN_CAP) { atomicAdd(&(bar)[XB_TMO], 1u); break; } } } } while (0)
struct XcdBarrier { unsigned* bar; unsigned x; volatile LAS unsigned* st; };
__device__ __forceinline__ XcdBarrier xcd_barrier_post(unsigned* bar, volatile LAS unsigned* st) {
    XcdBarrier b; b.bar = bar; b.x = xb_xcc_id(); b.st = st;
    if (threadIdx.x == 0) (void)xb_add(&bar[XB_XCNT(b.x)], 1u);
    return b;
}
__device__ __forceinline__ void xcd_barrier_complete(unsigned* bar, unsigned x, unsigned& nloc, unsigned& nx) {
    const unsigned G = gridDim.x * gridDim.y * gridDim.z;
    unsigned sum, cnt, mine, sp = 0u;
    for (;;) {
        sum = 0u; cnt = 0u; mine = 0u;
#pragma unroll
        for (unsigned j = 0; j < 16; ++j) { const unsigned c = xb_ld(&bar[XB_XCNT(j)]); sum += c; cnt += (c > 0u) ? 1u : 0u; mine = (j == x) ? c : mine; }
        if (sum == G) break;
        __builtin_amdgcn_s_sleep(1);
        if ((++sp & 255u) == 0u) { if (xb_ld(&bar[XB_TMO])) break; if (sp > XB_SPIN_CAP) { atomicAdd(&bar[XB_TMO], 1u); break; } }
    }
    nloc = mine > 0u ? mine : 1u; nx = cnt > 0u ? cnt : 1u;
}
__device__ __forceinline__ void xcd_barrier(const XcdBarrier& b) {
    asm volatile("s_waitcnt vmcnt(0)" ::: "memory");
    __syncthreads();
    if (threadIdx.x == 0) {
        unsigned* bar = b.bar;
        __builtin_amdgcn_s_waitcnt(0);
        unsigned nloc = b.st[0], nx = b.st[1];
        if (nloc == 0u) { xcd_barrier_complete(bar, b.x, nloc, nx); b.st[0] = nloc; b.st[1] = nx; }
        const unsigned old = xb_add(&bar[XB_XSUB(b.x)], 1u);
        const unsigned gen = old / nloc;
        if (old + 1u == (gen + 1u) * nloc) {
            __builtin_amdgcn_fence(__ATOMIC_RELEASE, "agent");
            asm volatile("s_waitcnt vmcnt(0)" ::: "memory");
            const unsigned og = xb_add(&bar[XB_TOP], 1u);
            const unsigned tg = og / nx;
            if (og + 1u == (tg + 1u) * nx) xb_add(&bar[XB_TOPGEN], 1u);
            else XB_SPIN(xb_ld(&bar[XB_TOPGEN]) == tg, bar);
            __builtin_amdgcn_fence(__ATOMIC_ACQUIRE, "agent");
            xb_add(&bar[XB_XGEN(b.x)], 1u);
            asm volatile("s_waitcnt vmcnt(0)" ::: "memory");
        } else {
            XB_SPIN(xb_ld(&bar[XB_XGEN(b.x)]) == gen, bar);
            __builtin_amdgcn_fence(__ATOMIC_ACQUIRE, "agent");
            asm volatile("s_waitcnt vmcnt(0)" ::: "memory");
        }
    }
    __syncthreads();
}

constexpr int NPHASE = 13;
constexpr int LDS_BYTES = 147456;
template <int MODE>
__device__ __forceinline__ void run_gemm(LAS unsigned char* lds, const bf16_t* A, const bf16_t* Bt, int N, int K, bf16_t* O, int ldc, const bf16_t* P1, const bf16_t* P2) {
    asm volatile("" : "+s"(K));
    pg8::Gemm g{A, Bt, K, K, pg8::BK * 2, K};
    pg8::StaticOrder S; S.init(T, N, (int)gridDim.x, (int)blockIdx.x, K);
    pg8::Epi<MODE> E{O, ldc, P1, P2, nullptr};
    pg8::gemm_phase<pg8::Epi<MODE>, pg8::StaticOrder, true>(lds, g, S, E);
}

__global__ void __launch_bounds__(512, 2) mk_fwd(Args a) {
    extern __shared__ __attribute__((aligned(16))) unsigned char lds_raw[];
    LAS unsigned char* lds = (LAS unsigned char*)lds_raw;
    const int G = gridDim.x, bid = blockIdx.x;
#define IDS() int tid = threadIdx.x; asm volatile("" : "+v"(tid)); const int lane = tid & 63, wid = __builtin_amdgcn_readfirstlane(tid >> 6); const int gw = bid * 8 + wid, ngw = G * 8; (void)gw; (void)ngw; (void)lane

    unsigned char* ws = a.ws;
    bf16_t* H = (bf16_t*)(ws + WS_H); bf16_t* Y = (bf16_t*)(ws + WS_Y); bf16_t* BIG = (bf16_t*)(ws + WS_BIG);
    cg::grid_group grid = cg::this_grid();
    if (a.ph_lo < 0) grid.sync();
    volatile LAS unsigned* MISCW = (volatile LAS unsigned*)(lds + LDS_BYTES - 64);
    if (threadIdx.x < 4) MISCW[threadIdx.x] = 0u;
    __syncthreads();
    XcdBarrier bar; bar.bar = (unsigned*)ws; bar.x = 0; bar.st = MISCW;
    if (a.ph_hi - a.ph_lo > 1) bar = xcd_barrier_post((unsigned*)ws, MISCW);
#ifndef PHASE_MASK
#define PHASE_MASK 0xFFFFF
#endif
#define IN(k) ((((PHASE_MASK) >> (k)) & 1) && a.ph_lo <= (k) && (k) < a.ph_hi)
#ifndef REPEAT_MASK
#define REPEAT_MASK 0
#endif
#define REP(k) for (int rep_ = 0; rep_ < ((((REPEAT_MASK) >> (k)) & 1) ? 2 : 1); ++rep_)
#define SEAM(k) do { if (IN(k) && IN((k) + 1)) xcd_barrier(bar); } while (0)

    if (IN(0)) REP(0) {
        IDS();
        int base = 0;
        for (int m = 0; m < W_NMAT; ++m) {
            const MatDesc md = mat_desc(m); const int nit = (md.K / 64) * (md.Nd / 64);
            int first = (gw - base % ngw + ngw) % ngw;
            for (int it = first; it < nit; it += ngw) transpose_item(a, m, it, lane);
            base += nit;
        }
        for (int t = gw; t < 64; t += ngw) {
            const int which = t >> 5, ch = t & 31; const float* pe = a.in[which ? 12 : 9]; const float* w1 = a.in[which ? 13 : 10];
            float s[4] = {0.f, 0.f, 0.f, 0.f};
            for (int k = 64 * ch; k < 64 * ch + 64; ++k) { const float p = pe[k];
#pragma unroll
                for (int j = 0; j < 4; ++j) s[j] += p * w1[(size_t)k * 256 + lane + 64 * j]; }
#pragma unroll
            for (int j = 0; j < 4; ++j) ((float*)(ws + WS_BIASP))[(size_t)t * 256 + lane + 64 * j] = s[j];
        }
        row_pass<false, false>(a.in[0], nullptr, 0.f, nullptr, nullptr, a.in[1], H, gw, ngw, lane);
    }
    SEAM(0);
#ifndef EXTRA_SYNC
#define EXTRA_SYNC 0
#endif
    for (int es_ = 0; es_ < EXTRA_SYNC; ++es_) xcd_barrier(bar);
    if (IN(1)) REP(1) run_gemm<pg8::EP_SWIGLU>(lds, H, (const bf16_t*)(ws + WS_WGU1), NGU, D, BIG, FF, nullptr, nullptr);
    SEAM(1);
    if (IN(2)) REP(2) run_gemm<pg8::EP_STORE>(lds, BIG, (const bf16_t*)(ws + WS_WD1), D, FF, Y, D, nullptr, nullptr);
    SEAM(2);
    if (IN(3)) REP(3) { IDS(); row_pass<false, true>(a.in[0], Y, 0.5f, a.in[2], a.out, a.in[6], H, gw, ngw, lane);
        if (bid == 0) { const float* bp = (const float*)(ws + WS_BIASP) + (size_t)(tid >> 8) * 32 * 256 + (tid & 255); float sbias = 0.f;
            for (int c = 0; c < 32; ++c) sbias += bp[c * 256];
            ((float*)(ws + WS_BIASP + 0x10000))[tid] = sbias; } }
    SEAM(3);
    if (IN(4)) REP(4) run_gemm<pg8::EP_PROJ>(lds, H, (const bf16_t*)(ws + WS_WIN), PITCH, D, BIG, PITCH, nullptr, nullptr);
    SEAM(4);
    if (IN(5)) REP(5) {
        { int tid0 = threadIdx.x; asm volatile("" : "+v"(tid0)); for (int u = bid; u < 32; u += G) unit_compress_full(a, u, lds, tid0); }
        IDS();
        int first, nmine, stride = 1;
        if (G == 256) {
            if (bid < 32) { first = 0; nmine = 0; }
            else { const int w = bid - 32; if (w < 192) { first = 7 * w; nmine = 7; } else { first = 1344 + 6 * (w - 192); nmine = 6; } }
        } else { first = bid; stride = G; nmine = bid < 1536 ? (1536 - bid + G - 1) / G : 0; }
        for (int k = 0; k < nmine; ++k) unit_dilated(a, first + k * stride, lds, tid, wid, lane);
    }
    SEAM(5);
    if (IN(6)) REP(6) {
        IDS();
        if (G == 256) {
            const int x = bid & 7, j = bid >> 3;
            for (int k = 0; k < 4; ++k) { const int p = x + 8 * (k >> 1); unit_nsa(a, p >> 1, p & 1, (k & 1) ? 63 - j : j, lds, tid, wid, lane); }
        } else { for (int u = bid; u < 1024; u += G) { int b, g, qb; gqa_decode(u, b, g, qb); unit_nsa(a, b, g, qb, lds, tid, wid, lane); } }
        dil_combine(a, bid * 512 + tid, G * 512);
    }
    SEAM(6);
    if (IN(7)) REP(7) {
        run_gemm<pg8::EP_SIG>(lds, H, (const bf16_t*)(ws + WS_WGA), D, D, Y, D, nullptr, nullptr);
        run_gemm<pg8::EP_MUL>(lds, (const bf16_t*)(ws + WS_ONSA), (const bf16_t*)(ws + WS_WN), D, 512, Y, D, Y, nullptr);
        run_gemm<pg8::EP_SIG>(lds, H, (const bf16_t*)(ws + WS_WGB), D, D, BIG, D, nullptr, nullptr);
        run_gemm<pg8::EP_FINAL>(lds, (const bf16_t*)(ws + WS_ODIL), (const bf16_t*)(ws + WS_WDIL), D, 256, Y, D, Y, BIG);
    }
    SEAM(7);
    if (IN(8)) REP(8) run_gemm<pg8::EP_STORE>(lds, Y, (const bf16_t*)(ws + WS_WMIX), D, D, BIG + (size_t)32 * MiB, D, nullptr, nullptr);
    SEAM(8);
    if (IN(9)) REP(9) { IDS(); row_pass<true, true>(a.out, BIG + (size_t)32 * MiB, 1.0f, a.in[7], ws + WS_ONSA, a.in[18], H, gw, ngw, lane); }
    SEAM(9);
    if (IN(10)) REP(10) run_gemm<pg8::EP_SWIGLU>(lds, H, (const bf16_t*)(ws + WS_WGU2), NGU, D, BIG, FF, nullptr, nullptr);
    SEAM(10);
    if (IN(11)) REP(11) run_gemm<pg8::EP_STORE>(lds, BIG, (const bf16_t*)(ws + WS_WD2), D, FF, Y, D, nullptr, nullptr);
    SEAM(11);
    if (IN(12)) REP(12) { IDS(); row_pass<true, false>(ws + WS_ONSA, Y, 0.5f, a.in[19], a.out, nullptr, nullptr, gw, ngw, lane); }
#undef IN
#undef SEAM
}

#ifndef MK_ONE_LAUNCH
#define MK_ONE_LAUNCH 1
#endif
extern "C" void kernel_launch(void* const* d_in, const int* in_sizes, int n_in, void* d_out, int out_size, void* d_ws, size_t ws_size, hipStream_t stream) {
    static int grid = 0;
    if (grid == 0) {
        if (n_in != 23 || ws_size < WS_END) { fprintf(stderr, "kernel_launch: unexpected n_in %d / ws_size %zu\n", n_in, ws_size); grid = -1; return; }
        int dev = 0, cus = 0, per_cu = 0;
        hipGetDevice(&dev); hipDeviceGetAttribute(&cus, hipDeviceAttributeMultiprocessorCount, dev);
        hipFuncSetAttribute((const void*)mk_fwd, hipFuncAttributeMaxDynamicSharedMemorySize, LDS_BYTES);
        hipOccupancyMaxActiveBlocksPerMultiprocessor(&per_cu, (const void*)mk_fwd, 512, LDS_BYTES);
        if (per_cu < 1) { fprintf(stderr, "kernel_launch: occupancy query returned %d\n", per_cu); per_cu = 1; }
        (void)hipGetLastError();
        grid = cus * 1;
    }
    if (grid < 0) return;
    if (hipMemsetAsync(d_ws, 0, 16384, stream) != hipSuccess) fprintf(stderr, "kernel_launch: memset failed\n");
    Args a{};
    for (int i = 0; i < 23; ++i) a.in[i] = (const float*)d_in[i];
    a.out = (float*)d_out; a.ws = (unsigned char*)d_ws;
#if MK_ONE_LAUNCH
    a.ph_lo = 0; a.ph_hi = NPHASE;
    void* args[] = {&a};
    hipError_t e = hipLaunchCooperativeKernel((const void*)mk_fwd, dim3(grid), dim3(512), args, LDS_BYTES, stream);
    if (e != hipSuccess) fprintf(stderr, "cooperative launch failed: %s (grid %d)\n", hipGetErrorString(e), grid);
#else
    for (int p = 0; p < NPHASE; ++p) { a.ph_lo = p; a.ph_hi = p + 1; hipLaunchKernelGGL(mk_fwd, dim3(grid), dim3(512), LDS_BYTES, stream, a); }
#endif
}
```

```cpp
#include <hip/hip_runtime.h>
#include <hip/hip_cooperative_groups.h>
#include <cstdio>
#include <cstdint>
namespace cg = cooperative_groups;

#define LAS __attribute__((address_space(3)))
typedef unsigned short bf16_t;
typedef short bf16x8 __attribute__((ext_vector_type(8)));
typedef short s16x4 __attribute__((ext_vector_type(4)));
typedef float f32x2 __attribute__((ext_vector_type(2)));
typedef float f32x4 __attribute__((ext_vector_type(4)));
typedef float f32x16 __attribute__((ext_vector_type(16)));
typedef unsigned u32x2 __attribute__((ext_vector_type(2)));
typedef unsigned u32x4 __attribute__((ext_vector_type(4)));

constexpr int BATCH = 8, SEQ = 4096, T = BATCH * SEQ, D = 1024, FF = 2816, NGU = 2 * FF;
constexpr int IN_DIM = 5656;
constexpr int PITCH = 3840;
constexpr int C_QN = 0, C_KV = 512, C_DIL = 1280, C_GN = 3584;
constexpr int NCMP = 255;
constexpr int QGP = 576;
constexpr size_t KVN_OFF = (size_t)T * QGP, DILS_OFF = KVN_OFF + (size_t)12 * T * 64;
constexpr float LOG2E = 1.4426950408889634f;
constexpr float RMS_EPS = 1e-6f;

constexpr size_t MiB = 1u << 20;
constexpr size_t WS_WGU1 = 2 * MiB, WS_WD1 = 13 * MiB, WS_WGU2 = 19 * MiB, WS_WD2 = 30 * MiB, WS_WIN = 36 * MiB;
constexpr size_t WS_WGA = 44 * MiB, WS_WGB = 46 * MiB, WS_WN = 48 * MiB, WS_WDIL = 49 * MiB, WS_WMIX = 50 * MiB;
constexpr size_t WS_WCK1 = 52 * MiB, WS_WCV1 = 53 * MiB;
constexpr size_t WS_BIASP = 54 * MiB, WS_KC = 54 * MiB + 0x20000, WS_VC = 54 * MiB + 0xA0000, WS_SELM = 54 * MiB + 0x120000;
constexpr size_t WS_CH = 56 * MiB, WS_H = 60 * MiB, WS_Y = 124 * MiB, WS_BIG = 188 * MiB, WS_ONSA = 428 * MiB, WS_ODIL = 460 * MiB;
constexpr size_t WS_END = 476 * MiB;
constexpr size_t WS_LSE = WS_Y + 48 * MiB;

__device__ __forceinline__ unsigned f2bf(float f) { unsigned u = __builtin_bit_cast(unsigned, f); return (u + 0x7fffu + ((u >> 16) & 1u)) >> 16; }
typedef __bf16 bf16x2_t __attribute__((ext_vector_type(2)));
__device__ __forceinline__ unsigned pk2(float lo, float hi) { f32x2 v = {lo, hi}; return __builtin_bit_cast(unsigned, __builtin_convertvector(v, bf16x2_t)); }
__device__ __forceinline__ float bflo(unsigned w) { return __builtin_bit_cast(float, w << 16); }
__device__ __forceinline__ float bfhi(unsigned w) { return __builtin_bit_cast(float, w & 0xffff0000u); }
__device__ __forceinline__ float sigmoidf_(float x) { return __builtin_amdgcn_rcpf(1.0f + __builtin_amdgcn_exp2f(-1.4426950408889634f * x)); }
__device__ __forceinline__ float wave_sum(float v) {
#pragma unroll
    for (int o = 1; o < 64; o <<= 1) v += __shfl_xor(v, o);
    return v;
}

namespace pg8 {
constexpr int BM = 256, BK = 64, HALF = 128, HTB = HALF * BK * 2, STAGE_BYTES = 8 * HTB, NXCD = 8, WGM = 8;
__host__ __device__ __forceinline__ int lds_byte(int r, int c) { const int st = (r >> 4) * 2 + (c >> 5), rr = r & 15, cc = c & 31, ob = rr * 64 + cc * 2; return st * 1024 + (ob ^ (((ob >> 9) & 1) << 5)); }
__host__ __device__ __forceinline__ void stage_rc(int b, int& R, int& C) { const int st = b / 1024, sb = b % 1024, swz = sb ^ (((sb >> 9) & 1) << 5); R = (st >> 1) * 16 + swz / 64; C = (st & 1) * 32 + (swz % 64) / 2; }
__host__ __device__ __forceinline__ int perm32(int rho) { const int n = rho >> 4, i = rho & 15; return 8 * (i >> 2) + 4 * n + (i & 3); }

struct Unit { int pm, pn; };
struct Gemm { const bf16_t* A; const bf16_t* Bt; int K; int lda; int kstepA; int ldb; };

struct StaticOrder {
    int nM, nN, nwg, G, c; size_t tstepA;
    __device__ void init(int M, int N, int G_, int c_, int lda) { nM = M / BM; nN = N / BM; nwg = nM * nN; G = G_; c = c_; tstepA = (size_t)BM * lda * 2; }
    __device__ bool next(int i, Unit& u) const {
        const long L = (long)i * G + c; if (L >= nwg) return false;
        int wgid = (int)L; { const int q = nwg / NXCD, r = nwg % NXCD, xcd = wgid % NXCD, off = wgid / NXCD; wgid = (xcd < r ? xcd * (q + 1) : r * (q + 1) + (xcd - r) * q) + off; }
        const int nig = WGM * nN, gid = wgid / nig, fm = gid * WGM, gsz = (nM - fm) < WGM ? (nM - fm) : WGM;
        u.pm = fm + ((wgid % nig) % gsz); u.pn = (wgid % nig) / gsz; return true;
    }
    __device__ __forceinline__ size_t aoff(const Unit& u) const { return (size_t)u.pm * tstepA; }
};
struct OneUnit {
    size_t off; int n;
    __device__ bool next(int i, Unit& u) const { if (i >= n) return false; u.pm = 0; u.pn = 0; return true; }
    __device__ __forceinline__ size_t aoff(const Unit&) const { return off; }
};

enum { EP_STORE = 0, EP_SIG = 1, EP_MUL = 2, EP_FINAL = 3, EP_SWIGLU = 4, EP_GELU = 5, EP_PROJ = 6 };
template <int MODE> struct Epi {
    static constexpr bool PERM = true;
    bf16_t* O; int ldc; const bf16_t* P1; const bf16_t* P2; const LAS float* bias;
    __device__ __forceinline__ void operator()(const f32x4 (&acc)[2][2][4][2], const Unit& u, int wr, int wc, int fr, int fq) const {
        const int row0 = u.pm * BM + wr * 64 + fr; const int col0 = u.pn * BM + wc * 32 + 8 * fq;
#pragma unroll
        for (int ai = 0; ai < 2; ++ai)
#pragma unroll
            for (int m = 0; m < 4; ++m) {
                const size_t rbase = (size_t)(row0 + ai * HALF + m * 16);
                if (MODE == EP_SWIGLU) {
                    float r[8];
#pragma unroll
                    for (int e = 0; e < 4; ++e) { const float g0 = acc[ai][0][m][0][e], g1 = acc[ai][0][m][1][e]; r[e] = g0 * sigmoidf_(g0) * acc[ai][1][m][0][e]; r[4 + e] = g1 * sigmoidf_(g1) * acc[ai][1][m][1][e]; }
                    u32x4 w; w.x = pk2(r[0], r[1]); w.y = pk2(r[2], r[3]); w.z = pk2(r[4], r[5]); w.w = pk2(r[6], r[7]);
                    *(u32x4*)(O + rbase * ldc + u.pn * HALF + wc * 32 + 8 * fq) = w;
                    asm volatile("" ::: "memory");
                    continue;
                }
#pragma unroll
                for (int bj = 0; bj < 2; ++bj) {
                    f32x4 v0 = acc[ai][bj][m][0], v1 = acc[ai][bj][m][1];
                    const int col = col0 + bj * HALF;
                    if (MODE == EP_SWIGLU) {
                    } else {
                        float r[8] = {v0[0], v0[1], v0[2], v0[3], v1[0], v1[1], v1[2], v1[3]};
                        size_t off = rbase * ldc + col;
                        if (MODE == EP_PROJ) {
                            const int row = (int)rbase;
                            if (u.pn < 2) off = rbase * QGP + col;
                            else if (u.pn < 5) off = KVN_OFF + ((size_t)((col - 512) >> 6) * T + row) * 64 + (col & 63);
                            else if (u.pn < 14) { const int c2 = col - 1280, slab = c2 >> 6, hd = slab % 12, sh = (hd >> 2) * 2  ;
                                const int sq = row & (SEQ - 1), sp = ((sq & ((1 << sh) - 1)) << (12 - sh)) + (sq >> sh);
                                off = DILS_OFF + ((size_t)slab * T + (row & ~(SEQ - 1)) + sp) * 64 + (col & 63); }
                            else { if (col - 3584 >= 64) continue; off = rbase * QGP + 512 + (col - 3584); }
                        }
                        if (MODE == EP_SIG) {
#pragma unroll
                            for (int e = 0; e < 8; ++e) r[e] = sigmoidf_(r[e]);
                        } else if (MODE == EP_MUL) {
                            const u32x4 p = *(const u32x4*)(P1 + off);
                            r[0] *= bflo(p.x); r[1] *= bfhi(p.x); r[2] *= bflo(p.y); r[3] *= bfhi(p.y); r[4] *= bflo(p.z); r[5] *= bfhi(p.z); r[6] *= bflo(p.w); r[7] *= bfhi(p.w);
                        } else if (MODE == EP_FINAL) {
                            const u32x4 p = *(const u32x4*)(P1 + off); const u32x4 q = *(const u32x4*)(P2 + off);
                            r[0] = bflo(p.x) + bflo(q.x) * r[0]; r[1] = bfhi(p.x) + bfhi(q.x) * r[1]; r[2] = bflo(p.y) + bflo(q.y) * r[2]; r[3] = bfhi(p.y) + bfhi(q.y) * r[3];
                            r[4] = bflo(p.z) + bflo(q.z) * r[4]; r[5] = bfhi(p.z) + bfhi(q.z) * r[5]; r[6] = bflo(p.w) + bflo(q.w) * r[6]; r[7] = bfhi(p.w) + bfhi(q.w) * r[7];
                        } else if (MODE == EP_GELU) {
#pragma unroll
                            for (int e = 0; e < 8; ++e) { const float x = r[e] + bias[col + e]; const float z = 0.7978845608028654f * (x + 0.044715f * x * x * x); r[e] = x * sigmoidf_(2.0f * z); }
                        }
                        u32x4 w; w.x = pk2(r[0], r[1]); w.y = pk2(r[2], r[3]); w.z = pk2(r[4], r[5]); w.w = pk2(r[6], r[7]);
                        *(u32x4*)(O + off) = w;
                    }
                    asm volatile("" ::: "memory");
                }
            }
    }
};

template <class EpiT, class Sched, bool ALIGN_EPI>
__device__ __forceinline__ void gemm_phase(LAS unsigned char* lds, const Gemm g, const Sched& S, const EpiT& E) {
    int tid_ = threadIdx.x; asm volatile("" : "+v"(tid_));
    const int tid = tid_, wid = __builtin_amdgcn_readfirstlane(tid >> 6), lane = tid & 63, wr = wid >> 2, wc = wid & 3, fr = lane & 15, fq = lane >> 4;
    const int K = g.K, nt = K / BK;
    unsigned voffA[2], voffB[2];
#pragma unroll
    for (int i = 0; i < 2; ++i) { int R, C; stage_rc(tid * 16 + i * 8192, R, C); const int Rb = EpiT::PERM ? ((R & ~31) + perm32(R & 31)) : R;
        voffA[i] = (unsigned)(R * g.lda + C) * 2u; voffB[i] = (unsigned)(Rb * g.ldb + C) * 2u; }
    const size_t kstepA = (size_t)g.kstepA, kstepB = (size_t)(BK * 2);
    const size_t hstepA = (size_t)HALF * g.lda * 2, hstepB = (size_t)HALF * g.ldb * 2, tstepB = 2 * hstepB;
    const unsigned ldsw = (unsigned)wid * 1024u;
    const int aoff = lds_byte(wr * 64 + fr, fq * 8), boff = lds_byte(wc * 32 + fr, fq * 8);
#define PG8_SA(b, h) (((b) * 2 + (h)) * HTB)
#define PG8_SB(b, h) ((4 + (b) * 2 + (h)) * HTB)
#define PG8_STAGE(bufoff, gbase, voff) do { _Pragma("unroll") for (int _i = 0; _i < 2; ++_i) \
        __builtin_amdgcn_global_load_lds((const unsigned*)((const char*)(gbase) + (voff)[_i]), (LAS unsigned*)(lds + (bufoff) + ldsw + _i * 8192), 16, 0, 0); } while (0)
#define PG8_LDA(dst, b, h) do { _Pragma("unroll") for (int m = 0; m < 4; ++m) _Pragma("unroll") for (int k = 0; k < 2; ++k) dst[m][k] = *(const LAS bf16x8*)(lds + PG8_SA(b, h) + aoff + m * 2048 + k * 1024); } while (0)
#define PG8_LDB(dst, b, h) do { _Pragma("unroll") for (int n = 0; n < 2; ++n) _Pragma("unroll") for (int k = 0; k < 2; ++k) dst[n][k] = *(const LAS bf16x8*)(lds + PG8_SB(b, h) + boff + n * 2048 + k * 1024); } while (0)
#define PG8_MMA(ai, bj, At, Bt) do { __builtin_amdgcn_s_setprio(1); _Pragma("unroll") for (int m = 0; m < 4; ++m) _Pragma("unroll") for (int n = 0; n < 2; ++n) _Pragma("unroll") for (int k = 0; k < 2; ++k) \
        acc[ai][bj][m][n] = __builtin_amdgcn_mfma_f32_16x16x32_bf16(Bt[n][k], At[m][k], acc[ai][bj][m][n], 0, 0, 0); __builtin_amdgcn_s_setprio(0); } while (0)
#define PG8_WAIT_V(n) asm volatile("s_waitcnt vmcnt(" #n ")" ::: "memory")
#define PG8_WAIT_L(n) asm volatile("s_waitcnt lgkmcnt(" #n ")" ::: "memory")
#define PG8_BAR __builtin_amdgcn_s_barrier()
#define PG8_SCHED __builtin_amdgcn_sched_barrier(0)
    Unit cur, nxt; int ui = 0;
    if (!S.next(0, cur)) return;
    f32x4 acc[2][2][4][2];
#pragma unroll
    for (int a = 0; a < 2; ++a)
#pragma unroll
        for (int b = 0; b < 2; ++b)
#pragma unroll
            for (int m = 0; m < 4; ++m)
#pragma unroll
                for (int n = 0; n < 2; ++n) acc[a][b][m][n] = (f32x4){0.f, 0.f, 0.f, 0.f};
    bf16x8 At[4][2], B0[2][2], B1[2][2];
    const char* cA = (const char*)g.A + S.aoff(cur); const char* cB = (const char*)g.Bt + (size_t)cur.pn * tstepB;
    PG8_STAGE(PG8_SB(0, 0), cB, voffB); PG8_STAGE(PG8_SB(0, 1), cB + hstepB, voffB); PG8_STAGE(PG8_SA(0, 0), cA, voffA); PG8_STAGE(PG8_SA(0, 1), cA + hstepA, voffA);
    if (wr == 1) PG8_BAR;
    PG8_WAIT_V(2); PG8_BAR;
    PG8_STAGE(PG8_SB(1, 0), cB + kstepB, voffB); PG8_STAGE(PG8_SA(1, 0), cA + kstepA, voffA); PG8_STAGE(PG8_SB(1, 1), cB + hstepB + kstepB, voffB);
    PG8_WAIT_V(6); PG8_BAR;
    for (;;) {
        const bool has_next = S.next(ui + 1, nxt);
        const char* nA = has_next ? (const char*)g.A + S.aoff(nxt) : cA; const char* nB = has_next ? (const char*)g.Bt + (size_t)nxt.pn * tstepB : cB;
        for (int t = 0; t < nt; t += 2) {
            const bool last = (t == nt - 2);
            const char* a1 = cA + (size_t)(t + 1) * kstepA;
            const char* a2 = last ? nA : cA + (size_t)(t + 2) * kstepA; const char* b2 = last ? nB : cB + (size_t)(t + 2) * kstepB;
            const char* a3 = a2 + kstepA; const char* b3 = b2 + kstepB;
            PG8_LDB(B0, 0, 0); PG8_LDB(B1, 0, 1); PG8_SCHED; PG8_LDA(At, 0, 0); PG8_STAGE(PG8_SA(1, 1), a1 + hstepA, voffA);
            PG8_WAIT_V(8); PG8_WAIT_L(0); PG8_BAR; PG8_MMA(0, 0, At, B0); PG8_MMA(0, 1, At, B1); PG8_BAR; PG8_SCHED;
            PG8_LDA(At, 0, 1); PG8_STAGE(PG8_SB(0, 0), b2, voffB); PG8_STAGE(PG8_SB(0, 1), b2 + hstepB, voffB); PG8_STAGE(PG8_SA(0, 0), a2, voffA);
            PG8_WAIT_V(8); PG8_WAIT_L(0); PG8_BAR; PG8_MMA(1, 0, At, B0); PG8_MMA(1, 1, At, B1); PG8_BAR; PG8_SCHED;
            PG8_LDB(B0, 1, 0); PG8_LDB(B1, 1, 1); PG8_SCHED; PG8_LDA(At, 1, 0); PG8_STAGE(PG8_SA(0, 1), a2 + hstepA, voffA);
            PG8_WAIT_V(8); PG8_WAIT_L(0); PG8_BAR; PG8_MMA(0, 0, At, B0); PG8_MMA(0, 1, At, B1); PG8_BAR; PG8_SCHED;
            PG8_LDA(At, 1, 1); PG8_STAGE(PG8_SB(1, 0), b3, voffB); PG8_STAGE(PG8_SB(1, 1), b3 + hstepB, voffB); PG8_STAGE(PG8_SA(1, 0), a3, voffA);
            PG8_WAIT_V(8); PG8_WAIT_L(0); PG8_BAR; PG8_MMA(1, 0, At, B0); PG8_MMA(1, 1, At, B1); PG8_BAR; PG8_SCHED;
        }
        if constexpr (ALIGN_EPI) { if (wr == 0) PG8_BAR; }
        E(acc, cur, wr, wc, fr, fq);
        if (!has_next) break;
#pragma unroll
        for (int a = 0; a < 2; ++a)
#pragma unroll
            for (int b = 0; b < 2; ++b)
#pragma unroll
                for (int m = 0; m < 4; ++m)
#pragma unroll
                    for (int n = 0; n < 2; ++n) acc[a][b][m][n] = (f32x4){0.f, 0.f, 0.f, 0.f};
        cur = nxt; cA = nA; cB = nB; ++ui;
        if constexpr (ALIGN_EPI) { if (wr == 1) PG8_BAR; }
    }
    PG8_WAIT_V(0);
    if constexpr (!ALIGN_EPI) { if (wr == 0) PG8_BAR; }
    PG8_BAR;
#undef PG8_SA
#undef PG8_SB
#undef PG8_STAGE
#undef PG8_LDA
#undef PG8_LDB
#undef PG8_MMA
#undef PG8_WAIT_V
#undef PG8_WAIT_L
#undef PG8_BAR
#undef PG8_SCHED
}
}

struct Args { const float* in[23]; float* out; unsigned char* ws; int ph_lo, ph_hi; };

enum { W_GU1 = 0, W_D1, W_GU2, W_D2, W_IN, W_GA, W_GB, W_N, W_DIL, W_MIX, W_CK1, W_CV1, W_CK2, W_CV2, W_NMAT };
struct MatDesc { int K, Nd; size_t wsoff; };
__device__ __forceinline__ MatDesc mat_desc(int m) {
    switch (m) {
        case W_GU1: return {D, NGU, WS_WGU1};
        case W_D1: return {FF, D, WS_WD1};
        case W_GU2: return {D, NGU, WS_WGU2};
        case W_D2: return {FF, D, WS_WD2};
        case W_IN: return {D, PITCH, WS_WIN};
        case W_GA: return {D, D, WS_WGA};
        case W_GB: return {D, D, WS_WGB};
        case W_N: return {512, D, WS_WN};
        case W_DIL: return {256, D, WS_WDIL};
        case W_MIX: return {D, D, WS_WMIX};
        case W_CK1: return {2048, 256, WS_WCK1};
        case W_CV1: return {2048, 256, WS_WCV1};
        case W_CK2: return {256, 64, WS_SELM};
        default: return {256, 64, WS_SELM + 0x8000};
    }
}
__device__ __forceinline__ const float* mat_src(const Args& a, int m, int n, int& ldw) {
    switch (m) {
        case W_GU1: case W_GU2: { ldw = FF; const int c = (n >> 8) * 128 + (n & 127); const int gi = (m == W_GU1) ? 3 : 20; return ((n & 128) ? a.in[gi + 1] : a.in[gi]) + c; }
        case W_D1: ldw = D; return a.in[5] + n;
        case W_D2: ldw = D; return a.in[22] + n;
        case W_IN: { ldw = IN_DIM; int c; if (n < 1280) c = n; else if (n < 3584) c = n + 24; else if (n < 3608) c = n - 3584 + 1280; else return nullptr; return a.in[8] + c; }
        case W_GA: ldw = IN_DIM; return a.in[8] + 3608 + n;
        case W_GB: ldw = IN_DIM; return a.in[8] + 4632 + n;
        case W_N: ldw = D; return a.in[15] + n;
        case W_DIL: ldw = D; return a.in[16] + n;
        case W_MIX: ldw = D; return a.in[17] + n;
        case W_CK1: ldw = 256; return a.in[10] + n;
        case W_CV1: ldw = 256; return a.in[13] + n;
        case W_CK2: ldw = 64; return a.in[11] + n;
        default: ldw = 64; return a.in[14] + n;
    }
}
__device__ __forceinline__ void transpose_item(const Args& a, int m, int item, int lane) {
    const MatDesc md = mat_desc(m);
    const int nblk = md.Nd / 64, kb = item / nblk, nb = item % nblk, k0 = 64 * kb, n0 = 64 * nb;
    int ldw = 0; const float* src = mat_src(a, m, n0 + lane, ldw);
    float v[64];
    if (src) {
        const float* p = src + (size_t)k0 * ldw;
#pragma unroll
        for (int kk = 0; kk < 64; ++kk) v[kk] = p[(size_t)kk * ldw];
    } else {
#pragma unroll
        for (int kk = 0; kk < 64; ++kk) v[kk] = 0.f;
    }
    u32x4* dst = (u32x4*)((bf16_t*)(a.ws + md.wsoff) + (size_t)(n0 + lane) * md.K + k0);
#pragma unroll
    for (int c = 0; c < 8; ++c) { u32x4 o; o.x = pk2(v[8 * c], v[8 * c + 1]); o.y = pk2(v[8 * c + 2], v[8 * c + 3]); o.z = pk2(v[8 * c + 4], v[8 * c + 5]); o.w = pk2(v[8 * c + 6], v[8 * c + 7]); dst[c] = o; }
}

template <bool XIN16, bool XO16>
__device__ __forceinline__ void row_pass(const void* xin_, const bf16_t* y, float scale, const float* gpost, void* xo_, const float* gnext, bf16_t* hout, int gw, int ngw, int lane) {
    const float* xin = (const float*)xin_; const bf16_t* xin16 = (const bf16_t*)xin_; float* xo = (float*)xo_; bf16_t* xo16 = (bf16_t*)xo_;
    f32x4 nv[4]; u32x2 ny[4];
#pragma unroll
    for (int j = 0; j < 4; ++j) { nv[j] = (f32x4){0.f, 0.f, 0.f, 0.f}; ny[j] = (u32x2){0u, 0u}; }
    if (gw < T) {
        if (XIN16) { const u32x2* xr = (const u32x2*)(xin16 + (size_t)gw * D) + lane;
#pragma unroll
            for (int j = 0; j < 4; ++j) { const u32x2 w = xr[64 * j]; nv[j] = (f32x4){bflo(w.x), bfhi(w.x), bflo(w.y), bfhi(w.y)}; } }
        else { const f32x4* xr = (const f32x4*)(xin + (size_t)gw * D) + lane;
#pragma unroll
            for (int j = 0; j < 4; ++j) nv[j] = xr[64 * j]; }
        if (y) { const u32x2* yr = (const u32x2*)(y + (size_t)gw * D) + lane;
#pragma unroll
            for (int j = 0; j < 4; ++j) ny[j] = yr[64 * j]; }
    }
    for (int m = gw; m < T; m += ngw) {
        f32x4 v[4]; u32x2 yw[4];
#pragma unroll
        for (int j = 0; j < 4; ++j) { v[j] = nv[j]; yw[j] = ny[j]; }
        const int mn = m + ngw;
        if (mn < T) {
            if (XIN16) { const u32x2* xr = (const u32x2*)(xin16 + (size_t)mn * D) + lane;
#pragma unroll
                for (int j = 0; j < 4; ++j) { const u32x2 w = xr[64 * j]; nv[j] = (f32x4){bflo(w.x), bfhi(w.x), bflo(w.y), bfhi(w.y)}; } }
            else { const f32x4* xr = (const f32x4*)(xin + (size_t)mn * D) + lane;
#pragma unroll
                for (int j = 0; j < 4; ++j) nv[j] = xr[64 * j]; }
            if (y) { const u32x2* yr = (const u32x2*)(y + (size_t)mn * D) + lane;
#pragma unroll
                for (int j = 0; j < 4; ++j) ny[j] = yr[64 * j]; }
        }
        if (y) {
            f32x4 yv[4]; float s = 0.f;
#pragma unroll
            for (int j = 0; j < 4; ++j) { const u32x2 w = yw[j]; yv[j] = (f32x4){bflo(w.x), bfhi(w.x), bflo(w.y), bfhi(w.y)}; s += (yv[j].x * yv[j].x + yv[j].y * yv[j].y) + (yv[j].z * yv[j].z + yv[j].w * yv[j].w); }
            const float rs = rsqrtf(wave_sum(s) * (1.f / D) + RMS_EPS) * scale;
#pragma unroll
            for (int j = 0; j < 4; ++j) { const f32x4 g = ((const f32x4*)gpost)[lane + 64 * j]; v[j] = v[j] + yv[j] * rs * g; }
            if (XO16) { u32x2* xw = (u32x2*)(xo16 + (size_t)m * D) + lane;
#pragma unroll
                for (int j = 0; j < 4; ++j) { u32x2 w; w.x = pk2(v[j].x, v[j].y); w.y = pk2(v[j].z, v[j].w); xw[64 * j] = w; } }
            else { f32x4* xw = (f32x4*)(xo + (size_t)m * D) + lane;
#pragma unroll
                for (int j = 0; j < 4; ++j) xw[64 * j] = v[j]; }
        }
        if (hout) {
            float s = 0.f;
#pragma unroll
            for (int j = 0; j < 4; ++j) s += (v[j].x * v[j].x + v[j].y * v[j].y) + (v[j].z * v[j].z + v[j].w * v[j].w);
            const float rs = rsqrtf(wave_sum(s) * (1.f / D) + RMS_EPS);
            u32x2* hw = (u32x2*)(hout + (size_t)m * D) + lane;
#pragma unroll
            for (int j = 0; j < 4; ++j) { const f32x4 g = ((const f32x4*)gnext)[lane + 64 * j]; const f32x4 o = v[j] * rs * g; u32x2 w; w.x = pk2(o.x, o.y); w.y = pk2(o.z, o.w); hw[64 * j] = w; }
        }
    }
}

constexpr int KP = 144, VP = 192;
constexpr int KST = 64 * KP, VST = 64 * VP;
constexpr int ATT_K0 = 0, ATT_V0 = 2 * KST;
constexpr int ATT_MISC = ATT_V0 + 2 * VST;
constexpr int ATT_SELL = ATT_MISC + 128;
constexpr int ATT_IMP = 44032;
constexpr int ATT_ACC = 110592;
enum { AT_BAND = 0, AT_CMP = 1, AT_SEL = 2 };
enum { MD_ONLINE = 0, MD_STATS = 1, MD_NORM = 2 };

__device__ __forceinline__ s16x4 tr16(const LAS unsigned char* p) {
    return __builtin_bit_cast(s16x4, __builtin_amdgcn_ds_read_tr16_b64_v4i16((LAS s16x4*)p));
}
__device__ __forceinline__ float xhalf_max(float m) {
    auto rr = __builtin_amdgcn_permlane32_swap(__builtin_bit_cast(unsigned, m), __builtin_bit_cast(unsigned, m), false, false);
    return fmaxf(__builtin_bit_cast(float, rr[0]), __builtin_bit_cast(float, rr[1]));
}

struct AttnWave {
    bf16x8 qf[4];
    f32x16 o[2];
    float kb[16];
    float m, l;
    int iq, i0w;
    int jlo, jhi;
    float c1, sb;
    int j0;
    int max_back;
    unsigned long long mysel;
    float mfin, invl;
    bool started;
};

template <int TYPE, int MODE>
__device__ __forceinline__ void attn_stage(AttnWave& W, const LAS unsigned char* Kl, const LAS unsigned char* Vl, int cur, int lane, LAS float* imp  , bool wave_skip_sel) {
    const int r32 = lane & 31, h = lane >> 5;
    const int jt = 64 * cur;
    {
        bool skip = (jt + 63 < W.jlo) || (jt > W.jhi);
        if (TYPE == AT_SEL) skip = skip || wave_skip_sel;
        if (TYPE == AT_CMP && MODE == MD_NORM) skip = false;
        if (skip) return;
    }
    bool lane_on = true;
    if (TYPE == AT_SEL) lane_on = ((W.mysel >> cur) & 1ull) != 0ull;
    const float ref = (MODE == MD_NORM) ? W.mfin : W.m;
    float base0 = W.sb * (float)(jt - W.j0) - ref;
    if (TYPE == AT_SEL) base0 = lane_on ? base0 : -INFINITY;
    const float base1 = base0 + 32.0f * W.sb;
    f32x16 s0, s1;
#pragma unroll
    for (int r = 0; r < 16; ++r) { s0[r] = W.kb[r] + base0; s1[r] = W.kb[r] + base1; }
    const LAS unsigned char* kp = Kl + r32 * KP + h * 16;
    bf16x8 kf0[4], kf1[4];
#pragma unroll
    for (int ds = 0; ds < 4; ++ds) { kf0[ds] = *(const LAS bf16x8*)(kp + ds * 32); kf1[ds] = *(const LAS bf16x8*)(kp + 32 * KP + ds * 32); }
    __builtin_amdgcn_sched_barrier(0);
#pragma unroll
    for (int ds = 0; ds < 4; ++ds) {
        s0 = __builtin_amdgcn_mfma_f32_32x32x16_bf16(kf0[ds], W.qf[ds], s0, 0, 0, 0);
        s1 = __builtin_amdgcn_mfma_f32_32x32x16_bf16(kf1[ds], W.qf[ds], s1, 0, 0, 0);
    }
    const LAS unsigned char* vp = Vl + (4 * h + ((lane & 15) >> 2)) * VP + (16 * ((lane >> 4) & 1) + 4 * (lane & 3)) * 2;
    s16x4 vlo[4][2], vhi[4][2];
    if (MODE != MD_STATS) {
#pragma unroll
        for (int s4 = 0; s4 < 4; ++s4)
#pragma unroll
            for (int blk = 0; blk < 2; ++blk) { vlo[s4][blk] = tr16(vp + (16 * s4) * VP + blk * 64); vhi[s4][blk] = tr16(vp + (16 * s4 + 8) * VP + blk * 64); }
    }
    __builtin_amdgcn_sched_barrier(0);
    float x0[16], x1[16];
#pragma unroll
    for (int r = 0; r < 16; ++r) { x0[r] = s0[r]; x1[r] = s1[r]; }
    if (TYPE == AT_BAND) {
        const bool interior = (jt + 63 <= W.i0w) && (W.i0w + 31 - jt <= W.max_back);
        if (!interior) {
            const int d = W.iq - jt - 4 * h;
#pragma unroll
            for (int r = 0; r < 16; ++r) { const int cr = (r & 3) + 8 * (r >> 2);
                x0[r] = ((unsigned)(d - cr) <= (unsigned)W.max_back) ? x0[r] : -INFINITY;
                x1[r] = ((unsigned)(d - 32 - cr) <= (unsigned)W.max_back) ? x1[r] : -INFINITY; }
        }
    } else if (TYPE == AT_CMP) {
        int lim = (W.iq - 31) >> 4; lim = lim > NCMP - 1 ? NCMP - 1 : lim; lim -= jt + 4 * h;
#pragma unroll
        for (int r = 0; r < 16; ++r) { const int cr = (r & 3) + 8 * (r >> 2); x0[r] = (cr <= lim) ? x0[r] : -INFINITY; x1[r] = (cr + 32 <= lim) ? x1[r] : -INFINITY; }
    } else {
        if (jt + 63 > W.i0w) {
            const int d = W.iq - jt - 4 * h;
#pragma unroll
            for (int r = 0; r < 16; ++r) { const int cr = (r & 3) + 8 * (r >> 2); x0[r] = (cr <= d) ? x0[r] : -INFINITY; x1[r] = (cr + 32 <= d) ? x1[r] : -INFINITY; }
        }
    }
    float p0[16], p1[16];
    if (MODE != MD_NORM) {
        float ma = fmaxf(fmaxf(x0[0], x0[1]), fmaxf(x0[2], x0[3])), mb = fmaxf(fmaxf(x1[0], x1[1]), fmaxf(x1[2], x1[3]));
#pragma unroll
        for (int r = 4; r < 16; r += 4) { ma = fmaxf(ma, fmaxf(fmaxf(x0[r], x0[r + 1]), fmaxf(x0[r + 2], x0[r + 3]))); mb = fmaxf(mb, fmaxf(fmaxf(x1[r], x1[r + 1]), fmaxf(x1[r + 2], x1[r + 3]))); }
        const float gmx = xhalf_max(fmaxf(ma, mb));
        const bool need = W.started ? (gmx > 60.0f) : (gmx > -INFINITY);
        if (__builtin_amdgcn_ballot_w64(need) != 0ull) {
            const float delta = need ? gmx : 0.f;
            const float f = W.started ? __builtin_amdgcn_exp2f(-delta) : 1.0f;
            W.m += delta; W.started = W.started || need;
            W.l *= f;
#pragma unroll
            for (int r = 0; r < 16; ++r) { x0[r] -= delta; x1[r] -= delta; }
            if (MODE == MD_ONLINE) {
#pragma unroll
                for (int r = 0; r < 16; ++r) { W.o[0][r] *= f; W.o[1][r] *= f; }
            }
        }
        float lsa = 0.f, lsb = 0.f;
#pragma unroll
        for (int r = 0; r < 16; ++r) { p0[r] = __builtin_amdgcn_exp2f(x0[r]); lsa += p0[r]; p1[r] = __builtin_amdgcn_exp2f(x1[r]); lsb += p1[r]; }
        W.l += lsa + lsb;
    } else {
#pragma unroll
        for (int r = 0; r < 16; ++r) { p0[r] = __builtin_amdgcn_exp2f(x0[r]) * W.invl; p1[r] = __builtin_amdgcn_exp2f(x1[r]) * W.invl; }
    }
    if (TYPE == AT_CMP && MODE == MD_NORM) {
#pragma unroll
        for (int hf = 0; hf < 2; ++hf)
#pragma unroll
            for (int i = 0; i < 4; ++i) {
                const float q0 = hf ? p1[4 * i] : p0[4 * i], q1 = hf ? p1[4 * i + 1] : p0[4 * i + 1], q2 = hf ? p1[4 * i + 2] : p0[4 * i + 2], q3 = hf ? p1[4 * i + 3] : p0[4 * i + 3];
                const float Bv = 0.5f * q3;
                const float A = (q0 + q1) + (q2 + Bv);
                const int u = 8 * (2 * cur + hf) + 2 * i + h;
                imp[u] += A;
                asm volatile("" ::: "memory");
                imp[u + 1] += Bv;
                asm volatile("" ::: "memory");
            }
    }
    if (MODE != MD_STATS) {
        bf16x8 pb[4];
#pragma unroll
        for (int s2 = 0; s2 < 2; ++s2) {
            u32x4 w; w.x = pk2(p0[8 * s2 + 0], p0[8 * s2 + 1]); w.y = pk2(p0[8 * s2 + 2], p0[8 * s2 + 3]); w.z = pk2(p0[8 * s2 + 4], p0[8 * s2 + 5]); w.w = pk2(p0[8 * s2 + 6], p0[8 * s2 + 7]);
            pb[s2] = __builtin_bit_cast(bf16x8, w);
            u32x4 z; z.x = pk2(p1[8 * s2 + 0], p1[8 * s2 + 1]); z.y = pk2(p1[8 * s2 + 2], p1[8 * s2 + 3]); z.z = pk2(p1[8 * s2 + 4], p1[8 * s2 + 5]); z.w = pk2(p1[8 * s2 + 6], p1[8 * s2 + 7]);
            pb[2 + s2] = __builtin_bit_cast(bf16x8, z);
        }
#pragma unroll
        for (int s4 = 0; s4 < 4; ++s4) {
#pragma unroll
            for (int blk = 0; blk < 2; ++blk) {
                const s16x4 lo = vlo[s4][blk], hi = vhi[s4][blk];
                const bf16x8 vf = (bf16x8){lo[0], lo[1], lo[2], lo[3], hi[0], hi[1], hi[2], hi[3]};
                W.o[blk] = __builtin_amdgcn_mfma_f32_32x32x16_bf16(vf, pb[s4], W.o[blk], 0, 0, 0);
            }
        }
    }
}

struct AttnUnitDesc {
    const bf16_t* K; const bf16_t* V; long kvstride; int jclamp;
    unsigned long long stmask;
};

template <int TYPE, int MODE, int NH = 1>
__device__ __forceinline__ void attn_run(AttnWave& W, const AttnUnitDesc& U, LAS unsigned char* lds, int tid, int lane, LAS float* imp, unsigned long long wavemask, int hsel = 0, size_t hstride = 0) {
    const int srow = tid >> 3, sch = tid & 7;
    constexpr int V0 = 2 * NH * KST;
    unsigned long long rem = U.stmask;
    int cur = 63 - __builtin_clzll(rem); rem &= ~(1ull << cur);
    u32x4 kreg[NH], vreg[NH];
    { int j = 64 * cur + srow; j = j > U.jclamp ? U.jclamp : j; const size_t off = (size_t)j * U.kvstride + sch * 8;
#pragma unroll
      for (int hs = 0; hs < NH; ++hs) { kreg[hs] = *(const u32x4*)(U.K + off + hs * hstride); vreg[hs] = *(const u32x4*)(U.V + off + hs * hstride); } }
    int buf = 0;
#pragma unroll
    for (int hs = 0; hs < NH; ++hs) { *(LAS u32x4*)(lds + hs * KST + srow * KP + sch * 16) = kreg[hs]; *(LAS u32x4*)(lds + V0 + hs * VST + srow * VP + sch * 16) = vreg[hs]; }
    __syncthreads();
    for (;;) {
        int nxt = -1;
        if (rem) { nxt = 63 - __builtin_clzll(rem); rem &= ~(1ull << nxt);
            int j = 64 * nxt + srow; j = j > U.jclamp ? U.jclamp : j; const size_t off = (size_t)j * U.kvstride + sch * 8;
#pragma unroll
            for (int hs = 0; hs < NH; ++hs) { kreg[hs] = *(const u32x4*)(U.K + off + hs * hstride); vreg[hs] = *(const u32x4*)(U.V + off + hs * hstride); } }
        const bool wskip = (TYPE == AT_SEL) ? (((wavemask >> cur) & 1ull) == 0ull) : false;
        attn_stage<TYPE, MODE>(W, lds + (buf * NH + hsel) * KST, lds + V0 + (buf * NH + hsel) * VST, cur, lane, imp, wskip);
        if (nxt < 0) break;
#pragma unroll
        for (int hs = 0; hs < NH; ++hs) { *(LAS u32x4*)(lds + ((buf ^ 1) * NH + hs) * KST + srow * KP + sch * 16) = kreg[hs]; *(LAS u32x4*)(lds + V0 + ((buf ^ 1) * NH + hs) * VST + srow * VP + sch * 16) = vreg[hs]; }
        __syncthreads();
        buf ^= 1; cur = nxt;
    }
    __syncthreads();
}

__device__ __forceinline__ void attn_init(AttnWave& W, int lane, int i0w, float slope_l2, int dstep) {
#pragma unroll
    for (int r = 0; r < 16; ++r) { W.o[0][r] = 0.f; W.o[1][r] = 0.f; }
    W.m = 0.f; W.l = 0.f; W.mysel = 0ull; W.mfin = 0.f; W.invl = 0.f; W.max_back = 0; W.started = false;
    W.i0w = i0w; W.iq = i0w + (lane & 31); W.c1 = 0.125f * LOG2E; W.sb = slope_l2 * (float)dstep;
#pragma unroll
    for (int r = 0; r < 16; ++r) W.kb[r] = W.sb * (float)((r & 3) + 8 * (r >> 2) + 4 * (lane >> 5));
}
__device__ __forceinline__ void load_q(AttnWave& W, const bf16_t* Qw, long qstride, int lane) {
    const int r32 = lane & 31, h = lane >> 5;
#pragma unroll
    for (int ds = 0; ds < 4; ++ds) {
        const u32x4 w = *(const u32x4*)(Qw + (size_t)r32 * qstride + 16 * ds + 8 * h); const float c = W.c1;
        u32x4 o; o.x = pk2(bflo(w.x) * c, bfhi(w.x) * c); o.y = pk2(bflo(w.y) * c, bfhi(w.y) * c); o.z = pk2(bflo(w.z) * c, bfhi(w.z) * c); o.w = pk2(bflo(w.w) * c, bfhi(w.w) * c);
        W.qf[ds] = __builtin_bit_cast(bf16x8, o);
    }
}

__device__ __forceinline__ float nsa_slope(int head) { return exp2f(-(float)(head + 1)); }
__device__ __forceinline__ void gqa_decode(int u, int& b, int& g, int& qb) {
    const int low6 = u & 63, hi4 = u >> 6, k = hi4 >> 2; b = hi4 >> 1; g = hi4 & 1;
    const int base = (low6 + 32 * (k >> 1)) & 63; qb = (k & 1) ? 63 - base : base;
}

__device__ __forceinline__ void unit_dilated(const Args& a, int id, LAS unsigned char* lds, int tid, int wid, int lane) {
    const int grp = id >> 9, rem = id & 511, b = rem >> 6, hp = (rem >> 5) & 1, sub = rem & 31;
    const int dil = grp == 0 ? 1 : (grp == 1 ? 4 : 16);
    const int r = sub % dil, ublk = sub / dil;
    const int hsel = wid >> 2, hi = 2 * hp + hsel;
    const bf16_t* slab0 = (const bf16_t*)(a.ws + WS_BIG) + DILS_OFF + ((size_t)(4 * grp + 2 * hp) * T + (size_t)b * SEQ + (size_t)r * (SEQ / dil)) * 64;
    const int i0w = 128 * ublk + 32 * (wid & 3);
    const float slope = exp2f(-8.0f * (float)(4 * grp + hi + 1) / 12.0f);
    AttnWave W; attn_init(W, lane, i0w, slope * LOG2E, dil);
    load_q(W, slab0 + (size_t)hsel * T * 64 + (size_t)i0w * 64, 64, lane);
    W.jlo = i0w - 128; W.jhi = i0w + 31; W.max_back = 128;
    const int slo = ublk > 0 ? 2 * ublk - 2 : 0, shi = 2 * ublk + 1; W.j0 = 64 * shi;
    AttnUnitDesc U; U.K = slab0 + (size_t)12 * T * 64; U.V = slab0 + (size_t)24 * T * 64; U.kvstride = 64; U.jclamp = SEQ / dil - 1;
    U.stmask = ((shi == 63) ? ~0ull : ((2ull << shi) - 1ull)) & ~((1ull << slo) - 1ull);
    attn_run<AT_BAND, MD_ONLINE, 2>(W, U, lds, tid, lane, nullptr, 0ull, hsel, (size_t)T * 64);
    const float lt = W.l + __shfl_xor(W.l, 32); const float inv = 1.0f / fmaxf(lt, 1e-30f);
    const size_t tok = (size_t)b * SEQ + (size_t)dil * W.iq + r;
    bf16_t* orow = (bf16_t*)(a.ws + WS_Y) + ((size_t)grp * T + tok) * 256 + hi * 64;
    const int h = lane >> 5;
#pragma unroll
    for (int blk = 0; blk < 2; ++blk)
#pragma unroll
        for (int i = 0; i < 4; ++i) { u32x2 w; w.x = pk2(W.o[blk][4 * i] * inv, W.o[blk][4 * i + 1] * inv); w.y = pk2(W.o[blk][4 * i + 2] * inv, W.o[blk][4 * i + 3] * inv);
            *(u32x2*)(orow + 32 * blk + 8 * i + 4 * h) = w; }
    if (h == 0) ((float*)(a.ws + WS_LSE))[((size_t)grp * T + tok) * 4 + hi] = (W.m + __log2f(lt) - W.sb * (float)(W.iq - W.j0)) * 0.6931471805599453f;
}

__device__ __forceinline__ void unit_nsa(const Args& a, int b, int g, int qb, LAS unsigned char* lds, int tid, int wid, int lane) {
    const bf16_t* big = (const bf16_t*)(a.ws + WS_BIG);
    const bf16_t* kvn = big + KVN_OFF + (size_t)b * SEQ * 64;
    const int hl = wid >> 1, head = g * 4 + hl, i0w = 64 * qb + 32 * (wid & 1);
    const float sl2 = nsa_slope(head) * LOG2E;
    LAS float* IMP = (LAS float*)(lds + ATT_IMP);
    for (int i = tid; i < 4 * 64 * 65; i += 512) IMP[i] = 0.f;
    const size_t tok = (size_t)b * SEQ + i0w + (lane & 31);
    const bf16_t* gp = big + tok * QGP + 512 + head * 3;
    const float g0 = sigmoidf_(bflo((unsigned)gp[0])), g1 = sigmoidf_(bflo((unsigned)gp[1])), g2 = sigmoidf_(bflo((unsigned)gp[2]));
    AttnWave W; AttnUnitDesc U;
    LAS u32x2* accl = (LAS u32x2*)(lds + ATT_ACC + wid * 4096) + lane;
    attn_init(W, lane, i0w, sl2, 1);
    load_q(W, big + ((size_t)b * SEQ + i0w) * QGP + head * 64, QGP, lane);
    {
        W.jlo = i0w - 511; W.jhi = i0w + 31; W.max_back = 511;
        const int slo = qb >= 8 ? qb - 8 : 0; W.j0 = 64 * qb;
        U.K = kvn + (size_t)(8 + g) * T * 64; U.V = kvn + (size_t)(10 + g) * T * 64; U.kvstride = 64; U.jclamp = SEQ - 1;
        U.stmask = ((qb == 63) ? ~0ull : ((2ull << qb) - 1ull)) & ~((1ull << slo) - 1ull);
        attn_run<AT_BAND, MD_ONLINE>(W, U, lds, tid, lane, nullptr, 0ull);
        const float lt = W.l + __shfl_xor(W.l, 32); const float sc = g2 / fmaxf(lt, 1e-30f);
#pragma unroll
        for (int blk = 0; blk < 2; ++blk)
#pragma unroll
            for (int i = 0; i < 4; ++i) { u32x2 w; w.x = pk2(W.o[blk][4 * i] * sc, W.o[blk][4 * i + 1] * sc); w.y = pk2(W.o[blk][4 * i + 2] * sc, W.o[blk][4 * i + 3] * sc); accl[(blk * 4 + i) * 64] = w; }
    }
    attn_init(W, lane, i0w, sl2, 16);
    {
        W.jlo = 0; W.jhi = i0w >> 4;
        const int cmax = 4 * qb + 2, shi = cmax >> 6; W.j0 = 64 * shi;
        U.K = (const bf16_t*)(a.ws + WS_KC) + (size_t)(b * 2 + g) * 256 * 64; U.V = (const bf16_t*)(a.ws + WS_VC) + (size_t)(b * 2 + g) * 256 * 64; U.kvstride = 64; U.jclamp = NCMP - 1;
        U.stmask = (2ull << shi) - 1ull;
        LAS float* impw = IMP + ((size_t)hl * 64 + 32 * (wid & 1) + (lane & 31)) * 65;
        attn_run<AT_CMP, MD_STATS>(W, U, lds, tid, lane, impw, 0ull);
        const float lt = W.l + __shfl_xor(W.l, 32);
        W.mfin = W.m; W.invl = 1.0f / fmaxf(lt, 1e-30f);
        attn_run<AT_CMP, MD_NORM>(W, U, lds, tid, lane, impw, 0ull);
#pragma unroll
        for (int blk = 0; blk < 2; ++blk)
#pragma unroll
            for (int i = 0; i < 4; ++i) { const u32x2 p = accl[(blk * 4 + i) * 64]; u32x2 w;
                w.x = pk2(bflo(p.x) + W.o[blk][4 * i] * g0, bfhi(p.x) + W.o[blk][4 * i + 1] * g0); w.y = pk2(bflo(p.y) + W.o[blk][4 * i + 2] * g0, bfhi(p.y) + W.o[blk][4 * i + 3] * g0); accl[(blk * 4 + i) * 64] = w; }
    }
    LAS unsigned long long* SELL = (LAS unsigned long long*)(lds + ATT_SELL);
    for (int qq = 8 * wid; qq < 8 * wid + 8; ++qq) {
        float val = ((IMP[(0 * 64 + qq) * 65 + lane] + IMP[(1 * 64 + qq) * 65 + lane]) + IMP[(2 * 64 + qq) * 65 + lane]) + IMP[(3 * 64 + qq) * 65 + lane];
        const int own = qb, j = lane;
        const bool forced = (j == 0) || (j == own) || (j == own - 1);
        const bool valid = j <= own;
        val = forced ? INFINITY : (valid ? val : -INFINITY);
        const unsigned key = (val == -INFINITY) ? 0u : (__builtin_bit_cast(unsigned, val) + 1u);
        unsigned Tk = 0u;
#pragma unroll
        for (int bit = 30; bit >= 0; --bit) { const unsigned c = Tk | (1u << bit); if (__builtin_popcountll(__ballot(key >= c)) >= 16) Tk = c; }
        unsigned long long msk = __ballot(key > Tk), eq = __ballot(key == Tk);
        for (int need = 16 - __builtin_popcountll(msk); need > 0; --need) { const unsigned long long low = eq & (0ull - eq); msk |= low; eq ^= low; }
        if (lane == 0) SELL[qq] = msk;
    }
    __syncthreads();
    attn_init(W, lane, i0w, sl2, 1);
    {
        W.jlo = 0; W.jhi = i0w + 31; W.j0 = 64 * qb;
        W.mysel = SELL[32 * (wid & 1) + (lane & 31)];
        unsigned lo = (unsigned)W.mysel, hi = (unsigned)(W.mysel >> 32);
#pragma unroll
        for (int o = 1; o < 64; o <<= 1) { lo |= __shfl_xor(lo, o); hi |= __shfl_xor(hi, o); }
        const unsigned long long wm = ((unsigned long long)hi << 32) | lo;
        unsigned long long um = 0ull;
#pragma unroll
        for (int q = 0; q < 64; ++q) um |= SELL[q];
        const unsigned long long causal = (qb == 63) ? ~0ull : ((2ull << qb) - 1ull);
        um &= causal; um |= 1ull;
        U.K = kvn + (size_t)(4 + g) * T * 64; U.V = kvn + (size_t)(6 + g) * T * 64; U.kvstride = 64; U.jclamp = SEQ - 1; U.stmask = um;
        attn_run<AT_SEL, MD_ONLINE>(W, U, lds, tid, lane, nullptr, wm);
        const float lt = W.l + __shfl_xor(W.l, 32); const float sc = g1 / fmaxf(lt, 1e-30f);
        bf16_t* orow = (bf16_t*)(a.ws + WS_ONSA) + tok * 512 + head * 64;
        const int h = lane >> 5;
#pragma unroll
        for (int blk = 0; blk < 2; ++blk)
#pragma unroll
            for (int i = 0; i < 4; ++i) { const u32x2 p = accl[(blk * 4 + i) * 64]; u32x2 w;
                w.x = pk2(bflo(p.x) + W.o[blk][4 * i] * sc, bfhi(p.x) + W.o[blk][4 * i + 1] * sc); w.y = pk2(bflo(p.y) + W.o[blk][4 * i + 2] * sc, bfhi(p.y) + W.o[blk][4 * i + 3] * sc);
                *(u32x2*)(orow + 32 * blk + 8 * i + 4 * h) = w; }
    }
}

constexpr int LDS_BIAS = 131072;
__device__ __forceinline__ void unit_compress_full(const Args& a, int id, LAS unsigned char* lds, int tid_in) {
    const int which = id >> 4, b = (id >> 1) & 7, g = id & 1;
    LAS float* bias = (LAS float*)(lds + LDS_BIAS);
    int tid = tid_in; asm volatile("" : "+v"(tid));
    if (tid < 256) bias[tid] = ((const float*)(a.ws + WS_BIASP + 0x10000))[which * 256 + tid];
    __syncthreads();
    bf16_t* CH = (bf16_t*)(a.ws + WS_CH) + (size_t)id * 65536;
    {
        int K = 2048; asm volatile("" : "+s"(K));
        pg8::Gemm gm{(const bf16_t*)(a.ws + WS_BIG), (const bf16_t*)(a.ws + (which ? WS_WCV1 : WS_WCK1)), K, 16 * 64, 128, 2048};
        int one = 1; asm volatile("" : "+s"(one));
        pg8::OneUnit S{(KVN_OFF + ((size_t)(which * 2 + g) * T + (size_t)b * SEQ) * 64) * 2, one};
        pg8::Epi<pg8::EP_STORE> E{CH, 256, nullptr, nullptr, nullptr};
        pg8::gemm_phase<pg8::Epi<pg8::EP_STORE>, pg8::OneUnit, true>(lds, gm, S, E);
    }
    __threadfence();
    __syncthreads();
    tid = tid_in; asm volatile("" : "+v"(tid));
    {
        const int lane = tid & 63, wv = tid >> 6, fr = lane & 15, fq = lane >> 4;
        const bf16_t* w2t = (const bf16_t*)(a.ws + WS_SELM + (which ? 0x8000 : 0));
        f32x4 acc[2][4];
#pragma unroll
        for (int rt = 0; rt < 2; ++rt)
#pragma unroll
            for (int ct = 0; ct < 4; ++ct) acc[rt][ct] = (f32x4){0.f, 0.f, 0.f, 0.f};
        for (int ks = 0; ks < 8; ++ks) {
            const int k0 = 32 * ks + 8 * fq;
            const f32x4 b0 = *(const LAS f32x4*)(bias + k0), b1 = *(const LAS f32x4*)(bias + k0 + 4);
            bf16x8 af[2], bfr[4];
#pragma unroll
            for (int rt = 0; rt < 2; ++rt) {
                const u32x4 hv = *(const u32x4*)(CH + (size_t)(32 * wv + 16 * rt + fr) * 256 + k0);
                float hx[8] = {bflo(hv.x) + b0.x, bfhi(hv.x) + b0.y, bflo(hv.y) + b0.z, bfhi(hv.y) + b0.w, bflo(hv.z) + b1.x, bfhi(hv.z) + b1.y, bflo(hv.w) + b1.z, bfhi(hv.w) + b1.w};
#pragma unroll
                for (int e = 0; e < 8; ++e) { const float x = hx[e]; const float z = 0.7978845608028654f * (x + 0.044715f * x * x * x); hx[e] = x * sigmoidf_(2.0f * z); }
                u32x4 w; w.x = pk2(hx[0], hx[1]); w.y = pk2(hx[2], hx[3]); w.z = pk2(hx[4], hx[5]); w.w = pk2(hx[6], hx[7]);
                af[rt] = __builtin_bit_cast(bf16x8, w);
            }
#pragma unroll
            for (int ct = 0; ct < 4; ++ct) bfr[ct] = *(const bf16x8*)(w2t + (size_t)(16 * ct + fr) * 256 + k0);
#pragma unroll
            for (int rt = 0; rt < 2; ++rt)
#pragma unroll
                for (int ct = 0; ct < 4; ++ct) acc[rt][ct] = __builtin_amdgcn_mfma_f32_16x16x32_bf16(bfr[ct], af[rt], acc[rt][ct], 0, 0, 0);
        }
        bf16_t* obase = (bf16_t*)(a.ws + (which ? WS_VC : WS_KC)) + (size_t)(b * 2 + g) * 256 * 64;
#pragma unroll
        for (int rt = 0; rt < 2; ++rt) { const int c = 32 * wv + 16 * rt + fr;
            if (c < NCMP) {
#pragma unroll
                for (int ct = 0; ct < 4; ++ct) { u32x2 w; w.x = pk2(acc[rt][ct][0], acc[rt][ct][1]); w.y = pk2(acc[rt][ct][2], acc[rt][ct][3]); *(u32x2*)(obase + (size_t)c * 64 + 16 * ct + 4 * fq) = w; }
            } }
    }
    __syncthreads();
}

__device__ __forceinline__ void dil_combine(const Args& a, int gtid, int ngt) {
    const bf16_t* odg = (const bf16_t*)(a.ws + WS_Y); const float* lse = (const float*)(a.ws + WS_LSE); bf16_t* od = (bf16_t*)(a.ws + WS_ODIL);
    for (size_t it = gtid; it < (size_t)T * 32; it += ngt) {
        const size_t tok = it >> 5; const int c8 = (int)(it & 31), hi = c8 >> 3;
        const float l0 = lse[tok * 4 + hi], l1 = lse[((size_t)T + tok) * 4 + hi], l2 = lse[((size_t)2 * T + tok) * 4 + hi];
        const float mx = fmaxf(l0, fmaxf(l1, l2));
        float w0 = __expf(l0 - mx), w1 = __expf(l1 - mx), w2 = __expf(l2 - mx); const float inv = 1.0f / (w0 + w1 + w2); w0 *= inv; w1 *= inv; w2 *= inv;
        const u32x4 p0 = *(const u32x4*)(odg + tok * 256 + c8 * 8), p1 = *(const u32x4*)(odg + ((size_t)T + tok) * 256 + c8 * 8), p2 = *(const u32x4*)(odg + ((size_t)2 * T + tok) * 256 + c8 * 8);
        u32x4 o;
        o.x = pk2(w0 * bflo(p0.x) + w1 * bflo(p1.x) + w2 * bflo(p2.x), w0 * bfhi(p0.x) + w1 * bfhi(p1.x) + w2 * bfhi(p2.x));
        o.y = pk2(w0 * bflo(p0.y) + w1 * bflo(p1.y) + w2 * bflo(p2.y), w0 * bfhi(p0.y) + w1 * bfhi(p1.y) + w2 * bfhi(p2.y));
        o.z = pk2(w0 * bflo(p0.z) + w1 * bflo(p1.z) + w2 * bflo(p2.z), w0 * bfhi(p0.z) + w1 * bfhi(p1.z) + w2 * bfhi(p2.z));
        o.w = pk2(w0 * bflo(p0.w) + w1 * bflo(p1.w) + w2 * bflo(p2.w), w0 * bfhi(p0.w) + w1 * bfhi(p1.w) + w2 * bfhi(p2.w));
        *(u32x4*)(od + tok * 256 + c8 * 8) = o;
    }
}


#define XB_TMO      128
#define XB_XCNT(j)  (256  + 64 * (j))
#define XB_XSUB(j)  (1280 + 64 * (j))
#define XB_XGEN(j)  (2304 + 64 * (j))
#define XB_TOP      3328
#define XB_TOPGEN   3392
#define XCD_BAR_WORDS 3456
#define XB_SPIN_CAP (1u << 18)
__device__ __forceinline__ unsigned xb_ld(unsigned* p)              { return __hip_atomic_load(p, __ATOMIC_RELAXED, __HIP_MEMORY_SCOPE_AGENT); }
__device__ __forceinline__ unsigned xb_add(unsigned* p, unsigned v) { return __hip_atomic_fetch_add(p, v, __ATOMIC_RELAXED, __HIP_MEMORY_SCOPE_AGENT); }
__device__ __forceinline__ unsigned xb_xcc_id() { return (unsigned)__builtin_amdgcn_s_getreg((3 << 11) | 20) & 0xFu; }
#define XB_SPIN(cond, bar) do { unsigned _sp = 0; while (cond) { __builtin_amdgcn_s_sleep(1); \
    if ((++_sp & 255u) == 0u) { if (xb_ld(&(bar)[XB_TMO])) break; if (_sp > XB_SPIN_CAP) { atomicAdd(&(bar)[XB_TMO], 1u); break; } } } } while (0)
struct XcdBarrier { unsigned* bar; unsigned x; volatile LAS unsigned* st; };
__device__ __forceinline__ XcdBarrier xcd_barrier_post(unsigned* bar, volatile LAS unsigned* st) {
    XcdBarrier b; b.bar = bar; b.x = xb_xcc_id(); b.st = st;
    if (threadIdx.x == 0) (void)xb_add(&bar[XB_XCNT(b.x)], 1u);
    return b;
}
__device__ __forceinline__ void xcd_barrier_complete(unsigned* bar, unsigned x, unsigned& nloc, unsigned& nx) {
    const unsigned G = gridDim.x * gridDim.y * gridDim.z;
    unsigned sum, cnt, mine, sp = 0u;
    for (;;) {
        sum = 0u; cnt = 0u; mine = 0u;
#pragma unroll
        for (unsigned j = 0; j < 16; ++j) { const unsigned c = xb_ld(&bar[XB_XCNT(j)]); sum += c; cnt += (c > 0u) ? 1u : 0u; mine = (j == x) ? c : mine; }
        if (sum == G) break;
        __builtin_amdgcn_s_sleep(1);
        if ((++sp & 255u) == 0u) { if (xb_ld(&bar[XB_TMO])) break; if (sp > XB_SPIN_CAP) { atomicAdd(&bar[XB_TMO], 1u); break; } }
    }
    nloc = mine > 0u ? mine : 1u; nx = cnt > 0u ? cnt : 1u;
}
__device__ __forceinline__ void xcd_barrier(const XcdBarrier& b) {
    asm volatile("s_waitcnt vmcnt(0)" ::: "memory");
    __syncthreads();
    if (threadIdx.x == 0) {
        unsigned* bar = b.bar;
        __builtin_amdgcn_s_waitcnt(0);
        unsigned nloc = b.st[0], nx = b.st[1];
        if (nloc == 0u) { xcd_barrier_complete(bar, b.x, nloc, nx); b.st[0] = nloc; b.st[1] = nx; }
        const unsigned old = xb_add(&bar[XB_XSUB(b.x)], 1u);
        const unsigned gen = old / nloc;
        if (old + 1u == (gen + 1u) * nloc) {
            __builtin_amdgcn_fence(__ATOMIC_RELEASE, "agent");
            asm volatile("s_waitcnt vmcnt(0)" ::: "memory");
            const unsigned og = xb_add(&bar[XB_TOP], 1u);
            const unsigned tg = og / nx;
            if (og + 1u == (tg + 1u) * nx) xb_add(&bar[XB_TOPGEN], 1u);
            else XB_SPIN(xb_ld(&bar[XB_TOPGEN]) == tg, bar);
            __builtin_amdgcn_fence(__ATOMIC_ACQUIRE, "agent");
            xb_add(&bar[XB_XGEN(b.x)], 1u);
            asm volatile("s_waitcnt vmcnt(0)" ::: "memory");
        } else {
            XB_SPIN(xb_ld(&bar[XB_XGEN(b.x)]) == gen, bar);
            __builtin_amdgcn_fence(__ATOMIC_ACQUIRE, "agent");
            asm volatile("s_waitcnt vmcnt(0)" ::: "memory");
        }
    }
    __syncthreads();
}

constexpr int NPHASE = 13;
constexpr int LDS_BYTES = 147456;
template <int MODE>
__device__ __forceinline__ void run_gemm(LAS unsigned char* lds, const bf16_t* A, const bf16_t* Bt, int N, int K, bf16_t* O, int ldc, const bf16_t* P1, const bf16_t* P2) {
    asm volatile("" : "+s"(K));
    pg8::Gemm g{A, Bt, K, K, pg8::BK * 2, K};
    pg8::StaticOrder S; S.init(T, N, (int)gridDim.x, (int)blockIdx.x, K);
    pg8::Epi<MODE> E{O, ldc, P1, P2, nullptr};
    pg8::gemm_phase<pg8::Epi<MODE>, pg8::StaticOrder, true>(lds, g, S, E);
}

__global__ void __launch_bounds__(512, 2) mk_fwd(Args a) {
    extern __shared__ __attribute__((aligned(16))) unsigned char lds_raw[];
    LAS unsigned char* lds = (LAS unsigned char*)lds_raw;
    const int G = gridDim.x, bid = blockIdx.x;
#define IDS() int tid = threadIdx.x; asm volatile("" : "+v"(tid)); const int lane = tid & 63, wid = __builtin_amdgcn_readfirstlane(tid >> 6); const int gw = bid * 8 + wid, ngw = G * 8; (void)gw; (void)ngw; (void)lane

    unsigned char* ws = a.ws;
    bf16_t* H = (bf16_t*)(ws + WS_H); bf16_t* Y = (bf16_t*)(ws + WS_Y); bf16_t* BIG = (bf16_t*)(ws + WS_BIG);
    cg::grid_group grid = cg::this_grid();
    if (a.ph_lo < 0) grid.sync();
    volatile LAS unsigned* MISCW = (volatile LAS unsigned*)(lds + LDS_BYTES - 64);
    if (threadIdx.x < 4) MISCW[threadIdx.x] = 0u;
    __syncthreads();
    XcdBarrier bar; bar.bar = (unsigned*)ws; bar.x = 0; bar.st = MISCW;
    if (a.ph_hi - a.ph_lo > 1) bar = xcd_barrier_post((unsigned*)ws, MISCW);
#ifndef PHASE_MASK
#define PHASE_MASK 0xFFFFF
#endif
#define IN(k) ((((PHASE_MASK) >> (k)) & 1) && a.ph_lo <= (k) && (k) < a.ph_hi)
#ifndef REPEAT_MASK
#define REPEAT_MASK 0
#endif
#define REP(k) for (int rep_ = 0; rep_ < ((((REPEAT_MASK) >> (k)) & 1) ? 2 : 1); ++rep_)
#define SEAM(k) do { if (IN(k) && IN((k) + 1)) xcd_barrier(bar); } while (0)

    if (IN(0)) REP(0) {
        IDS();
        int base = 0;
        for (int m = 0; m < W_NMAT; ++m) {
            const MatDesc md = mat_desc(m); const int nit = (md.K / 64) * (md.Nd / 64);
            int first = (gw - base % ngw + ngw) % ngw;
            for (int it = first; it < nit; it += ngw) transpose_item(a, m, it, lane);
            base += nit;
        }
        for (int t = gw; t < 64; t += ngw) {
            const int which = t >> 5, ch = t & 31; const float* pe = a.in[which ? 12 : 9]; const float* w1 = a.in[which ? 13 : 10];
            float s[4] = {0.f, 0.f, 0.f, 0.f};
            for (int k = 64 * ch; k < 64 * ch + 64; ++k) { const float p = pe[k];
#pragma unroll
                for (int j = 0; j < 4; ++j) s[j] += p * w1[(size_t)k * 256 + lane + 64 * j]; }
#pragma unroll
            for (int j = 0; j < 4; ++j) ((float*)(ws + WS_BIASP))[(size_t)t * 256 + lane + 64 * j] = s[j];
        }
        row_pass<false, false>(a.in[0], nullptr, 0.f, nullptr, nullptr, a.in[1], H, gw, ngw, lane);
    }
    SEAM(0);
#ifndef EXTRA_SYNC
#define EXTRA_SYNC 0
#endif
    for (int es_ = 0; es_ < EXTRA_SYNC; ++es_) xcd_barrier(bar);
    if (IN(1)) REP(1) run_gemm<pg8::EP_SWIGLU>(lds, H, (const bf16_t*)(ws + WS_WGU1), NGU, D, BIG, FF, nullptr, nullptr);
    SEAM(1);
    if (IN(2)) REP(2) run_gemm<pg8::EP_STORE>(lds, BIG, (const bf16_t*)(ws + WS_WD1), D, FF, Y, D, nullptr, nullptr);
    SEAM(2);
    if (IN(3)) REP(3) { IDS(); row_pass<false, true>(a.in[0], Y, 0.5f, a.in[2], a.out, a.in[6], H, gw, ngw, lane);
        if (bid == 0) { const float* bp = (const float*)(ws + WS_BIASP) + (size_t)(tid >> 8) * 32 * 256 + (tid & 255); float sbias = 0.f;
            for (int c = 0; c < 32; ++c) sbias += bp[c * 256];
            ((float*)(ws + WS_BIASP + 0x10000))[tid] = sbias; } }
    SEAM(3);
    if (IN(4)) REP(4) run_gemm<pg8::EP_PROJ>(lds, H, (const bf16_t*)(ws + WS_WIN), PITCH, D, BIG, PITCH, nullptr, nullptr);
    SEAM(4);
    if (IN(5)) REP(5) {
        { int tid0 = threadIdx.x; asm volatile("" : "+v"(tid0)); for (int u = bid; u < 32; u += G) unit_compress_full(a, u, lds, tid0); }
        IDS();
        int first, nmine, stride = 1;
        if (G == 256) {
            if (bid < 32) { first = 0; nmine = 0; }
            else { const int w = bid - 32; if (w < 192) { first = 7 * w; nmine = 7; } else { first = 1344 + 6 * (w - 192); nmine = 6; } }
        } else { first = bid; stride = G; nmine = bid < 1536 ? (1536 - bid + G - 1) / G : 0; }
        for (int k = 0; k < nmine; ++k) unit_dilated(a, first + k * stride, lds, tid, wid, lane);
    }
    SEAM(5);
    if (IN(6)) REP(6) {
        IDS();
        if (G == 256) {
            const int x = bid & 7, j = bid >> 3;
            for (int k = 0; k < 4; ++k) { const int p = x + 8 * (k >> 1); unit_nsa(a, p >> 1, p & 1, (k & 1) ? 63 - j : j, lds, tid, wid, lane); }
        } else { for (int u = bid; u < 1024; u += G) { int b, g, qb; gqa_decode(u, b, g, qb); unit_nsa(a, b, g, qb, lds, tid, wid, lane); } }
        dil_combine(a, bid * 512 + tid, G * 512);
    }
    SEAM(6);
    if (IN(7)) REP(7) {
        run_gemm<pg8::EP_SIG>(lds, H, (const bf16_t*)(ws + WS_WGA), D, D, Y, D, nullptr, nullptr);
        run_gemm<pg8::EP_MUL>(lds, (const bf16_t*)(ws + WS_ONSA), (const bf16_t*)(ws + WS_WN), D, 512, Y, D, Y, nullptr);
        run_gemm<pg8::EP_SIG>(lds, H, (const bf16_t*)(ws + WS_WGB), D, D, BIG, D, nullptr, nullptr);
        run_gemm<pg8::EP_FINAL>(lds, (const bf16_t*)(ws + WS_ODIL), (const bf16_t*)(ws + WS_WDIL), D, 256, Y, D, Y, BIG);
    }
    SEAM(7);
    if (IN(8)) REP(8) run_gemm<pg8::EP_STORE>(lds, Y, (const bf16_t*)(ws + WS_WMIX), D, D, BIG + (size_t)32 * MiB, D, nullptr, nullptr);
    SEAM(8);
    if (IN(9)) REP(9) { IDS(); row_pass<true, true>(a.out, BIG + (size_t)32 * MiB, 1.0f, a.in[7], ws + WS_ONSA, a.in[18], H, gw, ngw, lane); }
    SEAM(9);
    if (IN(10)) REP(10) run_gemm<pg8::EP_SWIGLU>(lds, H, (const bf16_t*)(ws + WS_WGU2), NGU, D, BIG, FF, nullptr, nullptr);
    SEAM(10);
    if (IN(11)) REP(11) run_gemm<pg8::EP_STORE>(lds, BIG, (const bf16_t*)(ws + WS_WD2), D, FF, Y, D, nullptr, nullptr);
    SEAM(11);
    if (IN(12)) REP(12) { IDS(); row_pass<true, false>(ws + WS_ONSA, Y, 0.5f, a.in[19], a.out, nullptr, nullptr, gw, ngw, lane); }
#undef IN
#undef SEAM
}

#ifndef MK_ONE_LAUNCH
#define MK_ONE_LAUNCH 1
#endif
extern "C" void kernel_launch(void* const* d_in, const int* in_sizes, int n_in, void* d_out, int out_size, void* d_ws, size_t ws_size, hipStream_t stream) {
    static int grid = 0;
    if (grid == 0) {
        if (n_in != 23 || ws_size < WS_END) { fprintf(stderr, "kernel_launch: unexpected n_in %d / ws_size %zu\n", n_in, ws_size); grid = -1; return; }
        int dev = 0, cus = 0, per_cu = 0;
        hipGetDevice(&dev); hipDeviceGetAttribute(&cus, hipDeviceAttributeMultiprocessorCount, dev);
        hipFuncSetAttribute((const void*)mk_fwd, hipFuncAttributeMaxDynamicSharedMemorySize, LDS_BYTES);
        hipOccupancyMaxActiveBlocksPerMultiprocessor(&per_cu, (const void*)mk_fwd, 512, LDS_BYTES);
        if (per_cu < 1) { fprintf(stderr, "kernel_launch: occupancy query returned %d\n", per_cu); per_cu = 1; }
        (void)hipGetLastError();
        grid = cus * 1;
    }
    if (grid < 0) return;
    if (hipMemsetAsync(d_ws, 0, 16384, stream) != hipSuccess) fprintf(stderr, "kernel_launch: memset failed\n");
    Args a{};
    for (int i = 0; i < 23; ++i) a.in[i] = (const float*)d_in[i];
    a.out = (float*)d_out; a.ws = (unsigned char*)d_ws;
#if MK_ONE_LAUNCH
    a.ph_lo = 0; a.ph_hi = NPHASE;
    void* args[] = {&a};
    hipError_t e = hipLaunchCooperativeKernel((const void*)mk_fwd, dim3(grid), dim3(512), args, LDS_BYTES, stream);
    if (e != hipSuccess) fprintf(stderr, "cooperative launch failed: %s (grid %d)\n", hipGetErrorString(e), grid);
#else
    for (int p = 0; p < NPHASE; ++p) { a.ph_lo = p; a.ph_hi = p + 1; hipLaunchKernelGGL(mk_fwd, dim3(grid), dim3(512), LDS_BYTES, stream, a); }
#endif
}
```

```cpp
#include <hip/hip_runtime.h>
#include <hip/hip_cooperative_groups.h>
#include <cstdio>
#include <cstdint>
namespace cg = cooperative_groups;

#define LAS __attribute__((address_space(3)))
typedef unsigned short bf16_t;
typedef short bf16x8 __attribute__((ext_vector_type(8)));
typedef short s16x4 __attribute__((ext_vector_type(4)));
typedef float f32x2 __attribute__((ext_vector_type(2)));
typedef float f32x4 __attribute__((ext_vector_type(4)));
typedef float f32x16 __attribute__((ext_vector_type(16)));
typedef unsigned u32x2 __attribute__((ext_vector_type(2)));
typedef unsigned u32x4 __attribute__((ext_vector_type(4)));

constexpr int BATCH = 8, SEQ = 4096, T = BATCH * SEQ, D = 1024, FF = 2816, NGU = 2 * FF;
constexpr int IN_DIM = 5656;
constexpr int PITCH = 3840;
constexpr int C_QN = 0, C_KV = 512, C_DIL = 1280, C_GN = 3584;
constexpr int NCMP = 255;
constexpr int QGP = 576;
constexpr size_t KVN_OFF = (size_t)T * QGP, DILS_OFF = KVN_OFF + (size_t)12 * T * 64;
constexpr float LOG2E = 1.4426950408889634f;
constexpr float RMS_EPS = 1e-6f;

constexpr size_t MiB = 1u << 20;
constexpr size_t WS_WGU1 = 2 * MiB, WS_WD1 = 13 * MiB, WS_WGU2 = 19 * MiB, WS_WD2 = 30 * MiB, WS_WIN = 36 * MiB;
constexpr size_t WS_WGA = 44 * MiB, WS_WGB = 46 * MiB, WS_WN = 48 * MiB, WS_WDIL = 49 * MiB, WS_WMIX = 50 * MiB;
constexpr size_t WS_WCK1 = 52 * MiB, WS_WCV1 = 53 * MiB;
constexpr size_t WS_BIASP = 54 * MiB, WS_KC = 54 * MiB + 0x20000, WS_VC = 54 * MiB + 0xA0000, WS_SELM = 54 * MiB + 0x120000;
constexpr size_t WS_CH = 56 * MiB, WS_H = 60 * MiB, WS_Y = 124 * MiB, WS_BIG = 188 * MiB, WS_ONSA = 428 * MiB, WS_ODIL = 460 * MiB;
constexpr size_t WS_END = 476 * MiB;
constexpr size_t WS_LSE = WS_Y + 48 * MiB;

__device__ __forceinline__ unsigned f2bf(float f) { unsigned u = __builtin_bit_cast(unsigned, f); return (u + 0x7fffu + ((u >> 16) & 1u)) >> 16; }
typedef __bf16 bf16x2_t __attribute__((ext_vector_type(2)));
__device__ __forceinline__ unsigned pk2(float lo, float hi) { f32x2 v = {lo, hi}; return __builtin_bit_cast(unsigned, __builtin_convertvector(v, bf16x2_t)); }
__device__ __forceinline__ float bflo(unsigned w) { return __builtin_bit_cast(float, w << 16); }
__device__ __forceinline__ float bfhi(unsigned w) { return __builtin_bit_cast(float, w & 0xffff0000u); }
__device__ __forceinline__ float sigmoidf_(float x) { return __builtin_amdgcn_rcpf(1.0f + __builtin_amdgcn_exp2f(-1.4426950408889634f * x)); }
__device__ __forceinline__ float wave_sum(float v) {
#pragma unroll
    for (int o = 1; o < 64; o <<= 1) v += __shfl_xor(v, o);
    return v;
}

namespace pg8 {
constexpr int BM = 256, BK = 64, HALF = 128, HTB = HALF * BK * 2, STAGE_BYTES = 8 * HTB, NXCD = 8, WGM = 4;
__host__ __device__ __forceinline__ int lds_byte(int r, int c) { const int st = (r >> 4) * 2 + (c >> 5), rr = r & 15, cc = c & 31, ob = rr * 64 + cc * 2; return st * 1024 + (ob ^ (((ob >> 9) & 1) << 5)); }
__host__ __device__ __forceinline__ void stage_rc(int b, int& R, int& C) { const int st = b / 1024, sb = b % 1024, swz = sb ^ (((sb >> 9) & 1) << 5); R = (st >> 1) * 16 + swz / 64; C = (st & 1) * 32 + (swz % 64) / 2; }
__host__ __device__ __forceinline__ int perm32(int rho) { const int n = rho >> 4, i = rho & 15; return 8 * (i >> 2) + 4 * n + (i & 3); }

struct Unit { int pm, pn; };
struct Gemm { const bf16_t* A; const bf16_t* Bt; int K; int lda; int kstepA; int ldb; };

struct StaticOrder {
    int nM, nN, nwg, G, c; size_t tstepA;
    __device__ void init(int M, int N, int G_, int c_, int lda) { nM = M / BM; nN = N / BM; nwg = nM * nN; G = G_; c = c_; tstepA = (size_t)BM * lda * 2; }
    __device__ bool next(int i, Unit& u) const {
        const long L = (long)i * G + c; if (L >= nwg) return false;
        int wgid = (int)L; { const int q = nwg / NXCD, r = nwg % NXCD, xcd = wgid % NXCD, off = wgid / NXCD; wgid = (xcd < r ? xcd * (q + 1) : r * (q + 1) + (xcd - r) * q) + off; }
        const int nig = WGM * nN, gid = wgid / nig, fm = gid * WGM, gsz = (nM - fm) < WGM ? (nM - fm) : WGM;
        u.pm = fm + ((wgid % nig) % gsz); u.pn = (wgid % nig) / gsz; return true;
    }
    __device__ __forceinline__ size_t aoff(const Unit& u) const { return (size_t)u.pm * tstepA; }
};
struct OneUnit {
    size_t off; int n;
    __device__ bool next(int i, Unit& u) const { if (i >= n) return false; u.pm = 0; u.pn = 0; return true; }
    __device__ __forceinline__ size_t aoff(const Unit&) const { return off; }
};

enum { EP_STORE = 0, EP_SIG = 1, EP_MUL = 2, EP_FINAL = 3, EP_SWIGLU = 4, EP_GELU = 5, EP_PROJ = 6 };
template <int MODE> struct Epi {
    static constexpr bool PERM = true;
    bf16_t* O; int ldc; const bf16_t* P1; const bf16_t* P2; const LAS float* bias;
    __device__ __forceinline__ void operator()(const f32x4 (&acc)[2][2][4][2], const Unit& u, int wr, int wc, int fr, int fq) const {
        const int row0 = u.pm * BM + wr * 64 + fr; const int col0 = u.pn * BM + wc * 32 + 8 * fq;
#pragma unroll
        for (int ai = 0; ai < 2; ++ai)
#pragma unroll
            for (int m = 0; m < 4; ++m) {
                const size_t rbase = (size_t)(row0 + ai * HALF + m * 16);
                if (MODE == EP_SWIGLU) {
                    float r[8];
#pragma unroll
                    for (int e = 0; e < 4; ++e) { const float g0 = acc[ai][0][m][0][e], g1 = acc[ai][0][m][1][e]; r[e] = g0 * sigmoidf_(g0) * acc[ai][1][m][0][e]; r[4 + e] = g1 * sigmoidf_(g1) * acc[ai][1][m][1][e]; }
                    u32x4 w; w.x = pk2(r[0], r[1]); w.y = pk2(r[2], r[3]); w.z = pk2(r[4], r[5]); w.w = pk2(r[6], r[7]);
                    *(u32x4*)(O + rbase * ldc + u.pn * HALF + wc * 32 + 8 * fq) = w;
                    asm volatile("" ::: "memory");
                    continue;
                }
#pragma unroll
                for (int bj = 0; bj < 2; ++bj) {
                    f32x4 v0 = acc[ai][bj][m][0], v1 = acc[ai][bj][m][1];
                    const int col = col0 + bj * HALF;
                    if (MODE == EP_SWIGLU) {
                    } else {
                        float r[8] = {v0[0], v0[1], v0[2], v0[3], v1[0], v1[1], v1[2], v1[3]};
                        size_t off = rbase * ldc + col;
                        if (MODE == EP_PROJ) {
                            const int row = (int)rbase;
                            if (u.pn < 2) off = rbase * QGP + col;
                            else if (u.pn < 5) off = KVN_OFF + ((size_t)((col - 512) >> 6) * T + row) * 64 + (col & 63);
                            else if (u.pn < 14) { const int c2 = col - 1280, slab = c2 >> 6, hd = slab % 12, sh = (hd >> 2) * 2  ;
                                const int sq = row & (SEQ - 1), sp = ((sq & ((1 << sh) - 1)) << (12 - sh)) + (sq >> sh);
                                off = DILS_OFF + ((size_t)slab * T + (row & ~(SEQ - 1)) + sp) * 64 + (col & 63); }
                            else { if (col - 3584 >= 64) continue; off = rbase * QGP + 512 + (col - 3584); }
                        }
                        if (MODE == EP_SIG) {
#pragma unroll
                            for (int e = 0; e < 8; ++e) r[e] = sigmoidf_(r[e]);
                        } else if (MODE == EP_MUL) {
                            const u32x4 p = *(const u32x4*)(P1 + off);
                            r[0] *= bflo(p.x); r[1] *= bfhi(p.x); r[2] *= bflo(p.y); r[3] *= bfhi(p.y); r[4] *= bflo(p.z); r[5] *= bfhi(p.z); r[6] *= bflo(p.w); r[7] *= bfhi(p.w);
                        } else if (MODE == EP_FINAL) {
                            const u32x4 p = *(const u32x4*)(P1 + off); const u32x4 q = *(const u32x4*)(P2 + off);
                            r[0] = bflo(p.x) + bflo(q.x) * r[0]; r[1] = bfhi(p.x) + bfhi(q.x) * r[1]; r[2] = bflo(p.y) + bflo(q.y) * r[2]; r[3] = bfhi(p.y) + bfhi(q.y) * r[3];
                            r[4] = bflo(p.z) + bflo(q.z) * r[4]; r[5] = bfhi(p.z) + bfhi(q.z) * r[5]; r[6] = bflo(p.w) + bflo(q.w) * r[6]; r[7] = bfhi(p.w) + bfhi(q.w) * r[7];
                        } else if (MODE == EP_GELU) {
#pragma unroll
                            for (int e = 0; e < 8; ++e) { const float x = r[e] + bias[col + e]; const float z = 0.7978845608028654f * (x + 0.044715f * x * x * x); r[e] = x * sigmoidf_(2.0f * z); }
                        }
                        u32x4 w; w.x = pk2(r[0], r[1]); w.y = pk2(r[2], r[3]); w.z = pk2(r[4], r[5]); w.w = pk2(r[6], r[7]);
                        *(u32x4*)(O + off) = w;
                    }
                    asm volatile("" ::: "memory");
                }
            }
    }
};

template <class EpiT, class Sched, bool ALIGN_EPI>
__device__ __forceinline__ void gemm_phase(LAS unsigned char* lds, const Gemm g, const Sched& S, const EpiT& E) {
    int tid_ = threadIdx.x; asm volatile("" : "+v"(tid_));
    const int tid = tid_, wid = __builtin_amdgcn_readfirstlane(tid >> 6), lane = tid & 63, wr = wid >> 2, wc = wid & 3, fr = lane & 15, fq = lane >> 4;
    const int K = g.K, nt = K / BK;
    unsigned voffA[2], voffB[2];
#pragma unroll
    for (int i = 0; i < 2; ++i) { int R, C; stage_rc(tid * 16 + i * 8192, R, C); const int Rb = EpiT::PERM ? ((R & ~31) + perm32(R & 31)) : R;
        voffA[i] = (unsigned)(R * g.lda + C) * 2u; voffB[i] = (unsigned)(Rb * g.ldb + C) * 2u; }
    const size_t kstepA = (size_t)g.kstepA, kstepB = (size_t)(BK * 2);
    const size_t hstepA = (size_t)HALF * g.lda * 2, hstepB = (size_t)HALF * g.ldb * 2, tstepB = 2 * hstepB;
    const unsigned ldsw = (unsigned)wid * 1024u;
    const int aoff = lds_byte(wr * 64 + fr, fq * 8), boff = lds_byte(wc * 32 + fr, fq * 8);
#define PG8_SA(b, h) (((b) * 2 + (h)) * HTB)
#define PG8_SB(b, h) ((4 + (b) * 2 + (h)) * HTB)
#define PG8_STAGE(bufoff, gbase, voff) do { _Pragma("unroll") for (int _i = 0; _i < 2; ++_i) \
        __builtin_amdgcn_global_load_lds((const unsigned*)((const char*)(gbase) + (voff)[_i]), (LAS unsigned*)(lds + (bufoff) + ldsw + _i * 8192), 16, 0, 0); } while (0)
#define PG8_LDA(dst, b, h) do { _Pragma("unroll") for (int m = 0; m < 4; ++m) _Pragma("unroll") for (int k = 0; k < 2; ++k) dst[m][k] = *(const LAS bf16x8*)(lds + PG8_SA(b, h) + aoff + m * 2048 + k * 1024); } while (0)
#define PG8_LDB(dst, b, h) do { _Pragma("unroll") for (int n = 0; n < 2; ++n) _Pragma("unroll") for (int k = 0; k < 2; ++k) dst[n][k] = *(const LAS bf16x8*)(lds + PG8_SB(b, h) + boff + n * 2048 + k * 1024); } while (0)
#define PG8_MMA(ai, bj, At, Bt) do { __builtin_amdgcn_s_setprio(1); _Pragma("unroll") for (int m = 0; m < 4; ++m) _Pragma("unroll") for (int n = 0; n < 2; ++n) _Pragma("unroll") for (int k = 0; k < 2; ++k) \
        acc[ai][bj][m][n] = __builtin_amdgcn_mfma_f32_16x16x32_bf16(Bt[n][k], At[m][k], acc[ai][bj][m][n], 0, 0, 0); __builtin_amdgcn_s_setprio(0); } while (0)
#define PG8_WAIT_V(n) asm volatile("s_waitcnt vmcnt(" #n ")" ::: "memory")
#define PG8_WAIT_L(n) asm volatile("s_waitcnt lgkmcnt(" #n ")" ::: "memory")
#define PG8_BAR __builtin_amdgcn_s_barrier()
#define PG8_SCHED __builtin_amdgcn_sched_barrier(0)
    Unit cur, nxt; int ui = 0;
    if (!S.next(0, cur)) return;
    f32x4 acc[2][2][4][2];
#pragma unroll
    for (int a = 0; a < 2; ++a)
#pragma unroll
        for (int b = 0; b < 2; ++b)
#pragma unroll
            for (int m = 0; m < 4; ++m)
#pragma unroll
                for (int n = 0; n < 2; ++n) acc[a][b][m][n] = (f32x4){0.f, 0.f, 0.f, 0.f};
    bf16x8 At[4][2], B0[2][2], B1[2][2];
    const char* cA = (const char*)g.A + S.aoff(cur); const char* cB = (const char*)g.Bt + (size_t)cur.pn * tstepB;
    PG8_STAGE(PG8_SB(0, 0), cB, voffB); PG8_STAGE(PG8_SB(0, 1), cB + hstepB, voffB); PG8_STAGE(PG8_SA(0, 0), cA, voffA); PG8_STAGE(PG8_SA(0, 1), cA + hstepA, voffA);
    if (wr == 1) PG8_BAR;
    PG8_WAIT_V(2); PG8_BAR;
    PG8_STAGE(PG8_SB(1, 0), cB + kstepB, voffB); PG8_STAGE(PG8_SA(1, 0), cA + kstepA, voffA); PG8_STAGE(PG8_SB(1, 1), cB + hstepB + kstepB, voffB);
    PG8_WAIT_V(6); PG8_BAR;
    for (;;) {
        const bool has_next = S.next(ui + 1, nxt);
        const char* nA = has_next ? (const char*)g.A + S.aoff(nxt) : cA; const char* nB = has_next ? (const char*)g.Bt + (size_t)nxt.pn * tstepB : cB;
        for (int t = 0; t < nt; t += 2) {
            const bool last = (t == nt - 2);
            const char* a1 = cA + (size_t)(t + 1) * kstepA;
            const char* a2 = last ? nA : cA + (size_t)(t + 2) * kstepA; const char* b2 = last ? nB : cB + (size_t)(t + 2) * kstepB;
            const char* a3 = a2 + kstepA; const char* b3 = b2 + kstepB;
            PG8_LDB(B0, 0, 0); PG8_LDB(B1, 0, 1); PG8_SCHED; PG8_LDA(At, 0, 0); PG8_STAGE(PG8_SA(1, 1), a1 + hstepA, voffA);
            PG8_WAIT_V(8); PG8_WAIT_L(0); PG8_BAR; PG8_MMA(0, 0, At, B0); PG8_MMA(0, 1, At, B1); PG8_BAR; PG8_SCHED;
            PG8_LDA(At, 0, 1); PG8_STAGE(PG8_SB(0, 0), b2, voffB); PG8_STAGE(PG8_SB(0, 1), b2 + hstepB, voffB); PG8_STAGE(PG8_SA(0, 0), a2, voffA);
            PG8_WAIT_V(8); PG8_WAIT_L(0); PG8_BAR; PG8_MMA(1, 0, At, B0); PG8_MMA(1, 1, At, B1); PG8_BAR; PG8_SCHED;
            PG8_LDB(B0, 1, 0); PG8_LDB(B1, 1, 1); PG8_SCHED; PG8_LDA(At, 1, 0); PG8_STAGE(PG8_SA(0, 1), a2 + hstepA, voffA);
            PG8_WAIT_V(8); PG8_WAIT_L(0); PG8_BAR; PG8_MMA(0, 0, At, B0); PG8_MMA(0, 1, At, B1); PG8_BAR; PG8_SCHED;
            PG8_LDA(At, 1, 1); PG8_STAGE(PG8_SB(1, 0), b3, voffB); PG8_STAGE(PG8_SB(1, 1), b3 + hstepB, voffB); PG8_STAGE(PG8_SA(1, 0), a3, voffA);
            PG8_WAIT_V(8); PG8_WAIT_L(0); PG8_BAR; PG8_MMA(1, 0, At, B0); PG8_MMA(1, 1, At, B1); PG8_BAR; PG8_SCHED;
        }
        if constexpr (ALIGN_EPI) { if (wr == 0) PG8_BAR; }
        E(acc, cur, wr, wc, fr, fq);
        if (!has_next) break;
#pragma unroll
        for (int a = 0; a < 2; ++a)
#pragma unroll
            for (int b = 0; b < 2; ++b)
#pragma unroll
                for (int m = 0; m < 4; ++m)
#pragma unroll
                    for (int n = 0; n < 2; ++n) acc[a][b][m][n] = (f32x4){0.f, 0.f, 0.f, 0.f};
        cur = nxt; cA = nA; cB = nB; ++ui;
        if constexpr (ALIGN_EPI) { if (wr == 1) PG8_BAR; }
    }
    PG8_WAIT_V(0);
    if constexpr (!ALIGN_EPI) { if (wr == 0) PG8_BAR; }
    PG8_BAR;
#undef PG8_SA
#undef PG8_SB
#undef PG8_STAGE
#undef PG8_LDA
#undef PG8_LDB
#undef PG8_MMA
#undef PG8_WAIT_V
#undef PG8_WAIT_L
#undef PG8_BAR
#undef PG8_SCHED
}
}

struct Args { const float* in[23]; float* out; unsigned char* ws; int ph_lo, ph_hi; };

enum { W_GU1 = 0, W_D1, W_GU2, W_D2, W_IN, W_GA, W_GB, W_N, W_DIL, W_MIX, W_CK1, W_CV1, W_CK2, W_CV2, W_NMAT };
struct MatDesc { int K, Nd; size_t wsoff; };
__device__ __forceinline__ MatDesc mat_desc(int m) {
    switch (m) {
        case W_GU1: return {D, NGU, WS_WGU1};
        case W_D1: return {FF, D, WS_WD1};
        case W_GU2: return {D, NGU, WS_WGU2};
        case W_D2: return {FF, D, WS_WD2};
        case W_IN: return {D, PITCH, WS_WIN};
        case W_GA: return {D, D, WS_WGA};
        case W_GB: return {D, D, WS_WGB};
        case W_N: return {512, D, WS_WN};
        case W_DIL: return {256, D, WS_WDIL};
        case W_MIX: return {D, D, WS_WMIX};
        case W_CK1: return {2048, 256, WS_WCK1};
        case W_CV1: return {2048, 256, WS_WCV1};
        case W_CK2: return {256, 64, WS_SELM};
        default: return {256, 64, WS_SELM + 0x8000};
    }
}
__device__ __forceinline__ const float* mat_src(const Args& a, int m, int n, int& ldw) {
    switch (m) {
        case W_GU1: case W_GU2: { ldw = FF; const int c = (n >> 8) * 128 + (n & 127); const int gi = (m == W_GU1) ? 3 : 20; return ((n & 128) ? a.in[gi + 1] : a.in[gi]) + c; }
        case W_D1: ldw = D; return a.in[5] + n;
        case W_D2: ldw = D; return a.in[22] + n;
        case W_IN: { ldw = IN_DIM; int c; if (n < 1280) c = n; else if (n < 3584) c = n + 24; else if (n < 3608) c = n - 3584 + 1280; else return nullptr; return a.in[8] + c; }
        case W_GA: ldw = IN_DIM; return a.in[8] + 3608 + n;
        case W_GB: ldw = IN_DIM; return a.in[8] + 4632 + n;
        case W_N: ldw = D; return a.in[15] + n;
        case W_DIL: ldw = D; return a.in[16] + n;
        case W_MIX: ldw = D; return a.in[17] + n;
        case W_CK1: ldw = 256; return a.in[10] + n;
        case W_CV1: ldw = 256; return a.in[13] + n;
        case W_CK2: ldw = 64; return a.in[11] + n;
        default: ldw = 64; return a.in[14] + n;
    }
}
__device__ __forceinline__ void transpose_item(const Args& a, int m, int item, int lane) {
    const MatDesc md = mat_desc(m);
    const int nblk = md.Nd / 64, kb = item / nblk, nb = item % nblk, k0 = 64 * kb, n0 = 64 * nb;
    int ldw = 0; const float* src = mat_src(a, m, n0 + lane, ldw);
    float v[64];
    if (src) {
        const float* p = src + (size_t)k0 * ldw;
#pragma unroll
        for (int kk = 0; kk < 64; ++kk) v[kk] = p[(size_t)kk * ldw];
    } else {
#pragma unroll
        for (int kk = 0; kk < 64; ++kk) v[kk] = 0.f;
    }
    u32x4* dst = (u32x4*)((bf16_t*)(a.ws + md.wsoff) + (size_t)(n0 + lane) * md.K + k0);
#pragma unroll
    for (int c = 0; c < 8; ++c) { u32x4 o; o.x = pk2(v[8 * c], v[8 * c + 1]); o.y = pk2(v[8 * c + 2], v[8 * c + 3]); o.z = pk2(v[8 * c + 4], v[8 * c + 5]); o.w = pk2(v[8 * c + 6], v[8 * c + 7]); dst[c] = o; }
}

template <bool XIN16, bool XO16>
__device__ __forceinline__ void row_pass(const void* xin_, const bf16_t* y, float scale, const float* gpost, void* xo_, const float* gnext, bf16_t* hout, int gw, int ngw, int lane) {
    const float* xin = (const float*)xin_; const bf16_t* xin16 = (const bf16_t*)xin_; float* xo = (float*)xo_; bf16_t* xo16 = (bf16_t*)xo_;
    f32x4 nv[4]; u32x2 ny[4];
#pragma unroll
    for (int j = 0; j < 4; ++j) { nv[j] = (f32x4){0.f, 0.f, 0.f, 0.f}; ny[j] = (u32x2){0u, 0u}; }
    if (gw < T) {
        if (XIN16) { const u32x2* xr = (const u32x2*)(xin16 + (size_t)gw * D) + lane;
#pragma unroll
            for (int j = 0; j < 4; ++j) { const u32x2 w = xr[64 * j]; nv[j] = (f32x4){bflo(w.x), bfhi(w.x), bflo(w.y), bfhi(w.y)}; } }
        else { const f32x4* xr = (const f32x4*)(xin + (size_t)gw * D) + lane;
#pragma unroll
            for (int j = 0; j < 4; ++j) nv[j] = xr[64 * j]; }
        if (y) { const u32x2* yr = (const u32x2*)(y + (size_t)gw * D) + lane;
#pragma unroll
            for (int j = 0; j < 4; ++j) ny[j] = yr[64 * j]; }
    }
    for (int m = gw; m < T; m += ngw) {
        f32x4 v[4]; u32x2 yw[4];
#pragma unroll
        for (int j = 0; j < 4; ++j) { v[j] = nv[j]; yw[j] = ny[j]; }
        const int mn = m + ngw;
        if (mn < T) {
            if (XIN16) { const u32x2* xr = (const u32x2*)(xin16 + (size_t)mn * D) + lane;
#pragma unroll
                for (int j = 0; j < 4; ++j) { const u32x2 w = xr[64 * j]; nv[j] = (f32x4){bflo(w.x), bfhi(w.x), bflo(w.y), bfhi(w.y)}; } }
            else { const f32x4* xr = (const f32x4*)(xin + (size_t)mn * D) + lane;
#pragma unroll
                for (int j = 0; j < 4; ++j) nv[j] = xr[64 * j]; }
            if (y) { const u32x2* yr = (const u32x2*)(y + (size_t)mn * D) + lane;
#pragma unroll
                for (int j = 0; j < 4; ++j) ny[j] = yr[64 * j]; }
        }
        if (y) {
            f32x4 yv[4]; float s = 0.f;
#pragma unroll
            for (int j = 0; j < 4; ++j) { const u32x2 w = yw[j]; yv[j] = (f32x4){bflo(w.x), bfhi(w.x), bflo(w.y), bfhi(w.y)}; s += (yv[j].x * yv[j].x + yv[j].y * yv[j].y) + (yv[j].z * yv[j].z + yv[j].w * yv[j].w); }
            const float rs = rsqrtf(wave_sum(s) * (1.f / D) + RMS_EPS) * scale;
#pragma unroll
            for (int j = 0; j < 4; ++j) { const f32x4 g = ((const f32x4*)gpost)[lane + 64 * j]; v[j] = v[j] + yv[j] * rs * g; }
            if (XO16) { u32x2* xw = (u32x2*)(xo16 + (size_t)m * D) + lane;
#pragma unroll
                for (int j = 0; j < 4; ++j) { u32x2 w; w.x = pk2(v[j].x, v[j].y); w.y = pk2(v[j].z, v[j].w); xw[64 * j] = w; } }
            else { f32x4* xw = (f32x4*)(xo + (size_t)m * D) + lane;
#pragma unroll
                for (int j = 0; j < 4; ++j) xw[64 * j] = v[j]; }
        }
        if (hout) {
            float s = 0.f;
#pragma unroll
            for (int j = 0; j < 4; ++j) s += (v[j].x * v[j].x + v[j].y * v[j].y) + (v[j].z * v[j].z + v[j].w * v[j].w);
            const float rs = rsqrtf(wave_sum(s) * (1.f / D) + RMS_EPS);
            u32x2* hw = (u32x2*)(hout + (size_t)m * D) + lane;
#pragma unroll
            for (int j = 0; j < 4; ++j) { const f32x4 g = ((const f32x4*)gnext)[lane + 64 * j]; const f32x4 o = v[j] * rs * g; u32x2 w; w.x = pk2(o.x, o.y); w.y = pk2(o.z, o.w); hw[64 * j] = w; }
        }
    }
}

constexpr int KP = 144, VP = 192;
constexpr int KST = 64 * KP, VST = 64 * VP;
constexpr int ATT_K0 = 0, ATT_V0 = 2 * KST;
constexpr int ATT_MISC = ATT_V0 + 2 * VST;
constexpr int ATT_SELL = ATT_MISC + 128;
constexpr int ATT_IMP = 44032;
constexpr int ATT_ACC = 110592;
enum { AT_BAND = 0, AT_CMP = 1, AT_SEL = 2 };
enum { MD_ONLINE = 0, MD_STATS = 1, MD_NORM = 2 };

__device__ __forceinline__ s16x4 tr16(const LAS unsigned char* p) {
    return __builtin_bit_cast(s16x4, __builtin_amdgcn_ds_read_tr16_b64_v4i16((LAS s16x4*)p));
}
__device__ __forceinline__ float xhalf_max(float m) {
    auto rr = __builtin_amdgcn_permlane32_swap(__builtin_bit_cast(unsigned, m), __builtin_bit_cast(unsigned, m), false, false);
    return fmaxf(__builtin_bit_cast(float, rr[0]), __builtin_bit_cast(float, rr[1]));
}

struct AttnWave {
    bf16x8 qf[4];
    f32x16 o[2];
    float kb[16];
    float m, l;
    int iq, i0w;
    int jlo, jhi;
    float c1, sb;
    int j0;
    int max_back;
    unsigned long long mysel;
    float mfin, invl;
    bool started;
};

template <int TYPE, int MODE>
__device__ __forceinline__ void attn_stage(AttnWave& W, const LAS unsigned char* Kl, const LAS unsigned char* Vl, int cur, int lane, LAS float* imp  , bool wave_skip_sel) {
    const int r32 = lane & 31, h = lane >> 5;
    const int jt = 64 * cur;
    {
        bool skip = (jt + 63 < W.jlo) || (jt > W.jhi);
        if (TYPE == AT_SEL) skip = skip || wave_skip_sel;
        if (TYPE == AT_CMP && MODE == MD_NORM) skip = false;
        if (skip) return;
    }
    bool lane_on = true;
    if (TYPE == AT_SEL) lane_on = ((W.mysel >> cur) & 1ull) != 0ull;
    const float ref = (MODE == MD_NORM) ? W.mfin : W.m;
    float base0 = W.sb * (float)(jt - W.j0) - ref;
    if (TYPE == AT_SEL) base0 = lane_on ? base0 : -INFINITY;
    const float base1 = base0 + 32.0f * W.sb;
    f32x16 s0, s1;
#pragma unroll
    for (int r = 0; r < 16; ++r) { s0[r] = W.kb[r] + base0; s1[r] = W.kb[r] + base1; }
    const LAS unsigned char* kp = Kl + r32 * KP + h * 16;
    bf16x8 kf0[4], kf1[4];
#pragma unroll
    for (int ds = 0; ds < 4; ++ds) { kf0[ds] = *(const LAS bf16x8*)(kp + ds * 32); kf1[ds] = *(const LAS bf16x8*)(kp + 32 * KP + ds * 32); }
    __builtin_amdgcn_sched_barrier(0);
#pragma unroll
    for (int ds = 0; ds < 4; ++ds) {
        s0 = __builtin_amdgcn_mfma_f32_32x32x16_bf16(kf0[ds], W.qf[ds], s0, 0, 0, 0);
        s1 = __builtin_amdgcn_mfma_f32_32x32x16_bf16(kf1[ds], W.qf[ds], s1, 0, 0, 0);
    }
    const LAS unsigned char* vp = Vl + (4 * h + ((lane & 15) >> 2)) * VP + (16 * ((lane >> 4) & 1) + 4 * (lane & 3)) * 2;
    s16x4 vlo[4][2], vhi[4][2];
    if (MODE != MD_STATS) {
#pragma unroll
        for (int s4 = 0; s4 < 4; ++s4)
#pragma unroll
            for (int blk = 0; blk < 2; ++blk) { vlo[s4][blk] = tr16(vp + (16 * s4) * VP + blk * 64); vhi[s4][blk] = tr16(vp + (16 * s4 + 8) * VP + blk * 64); }
    }
    __builtin_amdgcn_sched_barrier(0);
    float x0[16], x1[16];
#pragma unroll
    for (int r = 0; r < 16; ++r) { x0[r] = s0[r]; x1[r] = s1[r]; }
    if (TYPE == AT_BAND) {
        const bool interior = (jt + 63 <= W.i0w) && (W.i0w + 31 - jt <= W.max_back);
        if (!interior) {
            const int d = W.iq - jt - 4 * h;
#pragma unroll
            for (int r = 0; r < 16; ++r) { const int cr = (r & 3) + 8 * (r >> 2);
                x0[r] = ((unsigned)(d - cr) <= (unsigned)W.max_back) ? x0[r] : -INFINITY;
                x1[r] = ((unsigned)(d - 32 - cr) <= (unsigned)W.max_back) ? x1[r] : -INFINITY; }
        }
    } else if (TYPE == AT_CMP) {
        int lim = (W.iq - 31) >> 4; lim = lim > NCMP - 1 ? NCMP - 1 : lim; lim -= jt + 4 * h;
#pragma unroll
        for (int r = 0; r < 16; ++r) { const int cr = (r & 3) + 8 * (r >> 2); x0[r] = (cr <= lim) ? x0[r] : -INFINITY; x1[r] = (cr + 32 <= lim) ? x1[r] : -INFINITY; }
    } else {
        if (jt + 63 > W.i0w) {
            const int d = W.iq - jt - 4 * h;
#pragma unroll
            for (int r = 0; r < 16; ++r) { const int cr = (r & 3) + 8 * (r >> 2); x0[r] = (cr <= d) ? x0[r] : -INFINITY; x1[r] = (cr + 32 <= d) ? x1[r] : -INFINITY; }
        }
    }
    float p0[16], p1[16];
    if (MODE != MD_NORM) {
        float ma = fmaxf(fmaxf(x0[0], x0[1]), fmaxf(x0[2], x0[3])), mb = fmaxf(fmaxf(x1[0], x1[1]), fmaxf(x1[2], x1[3]));
#pragma unroll
        for (int r = 4; r < 16; r += 4) { ma = fmaxf(ma, fmaxf(fmaxf(x0[r], x0[r + 1]), fmaxf(x0[r + 2], x0[r + 3]))); mb = fmaxf(mb, fmaxf(fmaxf(x1[r], x1[r + 1]), fmaxf(x1[r + 2], x1[r + 3]))); }
        const float gmx = xhalf_max(fmaxf(ma, mb));
        const bool need = W.started ? (gmx > 60.0f) : (gmx > -INFINITY);
        if (__builtin_amdgcn_ballot_w64(need) != 0ull) {
            const float delta = need ? gmx : 0.f;
            const float f = W.started ? __builtin_amdgcn_exp2f(-delta) : 1.0f;
            W.m += delta; W.started = W.started || need;
            W.l *= f;
#pragma unroll
            for (int r = 0; r < 16; ++r) { x0[r] -= delta; x1[r] -= delta; }
            if (MODE == MD_ONLINE) {
#pragma unroll
                for (int r = 0; r < 16; ++r) { W.o[0][r] *= f; W.o[1][r] *= f; }
            }
        }
        float lsa = 0.f, lsb = 0.f;
#pragma unroll
        for (int r = 0; r < 16; ++r) { p0[r] = __builtin_amdgcn_exp2f(x0[r]); lsa += p0[r]; p1[r] = __builtin_amdgcn_exp2f(x1[r]); lsb += p1[r]; }
        W.l += lsa + lsb;
    } else {
#pragma unroll
        for (int r = 0; r < 16; ++r) { p0[r] = __builtin_amdgcn_exp2f(x0[r]) * W.invl; p1[r] = __builtin_amdgcn_exp2f(x1[r]) * W.invl; }
    }
    if (TYPE == AT_CMP && MODE == MD_NORM) {
#pragma unroll
        for (int hf = 0; hf < 2; ++hf)
#pragma unroll
            for (int i = 0; i < 4; ++i) {
                const float q0 = hf ? p1[4 * i] : p0[4 * i], q1 = hf ? p1[4 * i + 1] : p0[4 * i + 1], q2 = hf ? p1[4 * i + 2] : p0[4 * i + 2], q3 = hf ? p1[4 * i + 3] : p0[4 * i + 3];
                const float Bv = 0.5f * q3;
                const float A = (q0 + q1) + (q2 + Bv);
                const int u = 8 * (2 * cur + hf) + 2 * i + h;
                imp[u] += A;
                asm volatile("" ::: "memory");
                imp[u + 1] += Bv;
                asm volatile("" ::: "memory");
            }
    }
    if (MODE != MD_STATS) {
        bf16x8 pb[4];
#pragma unroll
        for (int s2 = 0; s2 < 2; ++s2) {
            u32x4 w; w.x = pk2(p0[8 * s2 + 0], p0[8 * s2 + 1]); w.y = pk2(p0[8 * s2 + 2], p0[8 * s2 + 3]); w.z = pk2(p0[8 * s2 + 4], p0[8 * s2 + 5]); w.w = pk2(p0[8 * s2 + 6], p0[8 * s2 + 7]);
            pb[s2] = __builtin_bit_cast(bf16x8, w);
            u32x4 z; z.x = pk2(p1[8 * s2 + 0], p1[8 * s2 + 1]); z.y = pk2(p1[8 * s2 + 2], p1[8 * s2 + 3]); z.z = pk2(p1[8 * s2 + 4], p1[8 * s2 + 5]); z.w = pk2(p1[8 * s2 + 6], p1[8 * s2 + 7]);
            pb[2 + s2] = __builtin_bit_cast(bf16x8, z);
        }
#pragma unroll
        for (int s4 = 0; s4 < 4; ++s4) {
#pragma unroll
            for (int blk = 0; blk < 2; ++blk) {
                const s16x4 lo = vlo[s4][blk], hi = vhi[s4][blk];
                const bf16x8 vf = (bf16x8){lo[0], lo[1], lo[2], lo[3], hi[0], hi[1], hi[2], hi[3]};
                W.o[blk] = __builtin_amdgcn_mfma_f32_32x32x16_bf16(vf, pb[s4], W.o[blk], 0, 0, 0);
            }
        }
    }
}

struct AttnUnitDesc {
    const bf16_t* K; const bf16_t* V; long kvstride; int jclamp;
    unsigned long long stmask;
};

template <int TYPE, int MODE, int NH = 1>
__device__ __forceinline__ void attn_run(AttnWave& W, const AttnUnitDesc& U, LAS unsigned char* lds, int tid, int lane, LAS float* imp, unsigned long long wavemask, int hsel = 0, size_t hstride = 0) {
    const int srow = tid >> 3, sch = tid & 7;
    constexpr int V0 = 2 * NH * KST;
    unsigned long long rem = U.stmask;
    int cur = 63 - __builtin_clzll(rem); rem &= ~(1ull << cur);
    u32x4 kreg[NH], vreg[NH];
    { int j = 64 * cur + srow; j = j > U.jclamp ? U.jclamp : j; const size_t off = (size_t)j * U.kvstride + sch * 8;
#pragma unroll
      for (int hs = 0; hs < NH; ++hs) { kreg[hs] = *(const u32x4*)(U.K + off + hs * hstride); vreg[hs] = *(const u32x4*)(U.V + off + hs * hstride); } }
    int buf = 0;
#pragma unroll
    for (int hs = 0; hs < NH; ++hs) { *(LAS u32x4*)(lds + hs * KST + srow * KP + sch * 16) = kreg[hs]; *(LAS u32x4*)(lds + V0 + hs * VST + srow * VP + sch * 16) = vreg[hs]; }
    __syncthreads();
    for (;;) {
        int nxt = -1;
        if (rem) { nxt = 63 - __builtin_clzll(rem); rem &= ~(1ull << nxt);
            int j = 64 * nxt + srow; j = j > U.jclamp ? U.jclamp : j; const size_t off = (size_t)j * U.kvstride + sch * 8;
#pragma unroll
            for (int hs = 0; hs < NH; ++hs) { kreg[hs] = *(const u32x4*)(U.K + off + hs * hstride); vreg[hs] = *(const u32x4*)(U.V + off + hs * hstride); } }
        const bool wskip = (TYPE == AT_SEL) ? (((wavemask >> cur) & 1ull) == 0ull) : false;
        attn_stage<TYPE, MODE>(W, lds + (buf * NH + hsel) * KST, lds + V0 + (buf * NH + hsel) * VST, cur, lane, imp, wskip);
        if (nxt < 0) break;
#pragma unroll
        for (int hs = 0; hs < NH; ++hs) { *(LAS u32x4*)(lds + ((buf ^ 1) * NH + hs) * KST + srow * KP + sch * 16) = kreg[hs]; *(LAS u32x4*)(lds + V0 + ((buf ^ 1) * NH + hs) * VST + srow * VP + sch * 16) = vreg[hs]; }
        __syncthreads();
        buf ^= 1; cur = nxt;
    }
    __syncthreads();
}

__device__ __forceinline__ void attn_init(AttnWave& W, int lane, int i0w, float slope_l2, int dstep) {
#pragma unroll
    for (int r = 0; r < 16; ++r) { W.o[0][r] = 0.f; W.o[1][r] = 0.f; }
    W.m = 0.f; W.l = 0.f; W.mysel = 0ull; W.mfin = 0.f; W.invl = 0.f; W.max_back = 0; W.started = false;
    W.i0w = i0w; W.iq = i0w + (lane & 31); W.c1 = 0.125f * LOG2E; W.sb = slope_l2 * (float)dstep;
#pragma unroll
    for (int r = 0; r < 16; ++r) W.kb[r] = W.sb * (float)((r & 3) + 8 * (r >> 2) + 4 * (lane >> 5));
}
__device__ __forceinline__ void load_q(AttnWave& W, const bf16_t* Qw, long qstride, int lane) {
    const int r32 = lane & 31, h = lane >> 5;
#pragma unroll
    for (int ds = 0; ds < 4; ++ds) {
        const u32x4 w = *(const u32x4*)(Qw + (size_t)r32 * qstride + 16 * ds + 8 * h); const float c = W.c1;
        u32x4 o; o.x = pk2(bflo(w.x) * c, bfhi(w.x) * c); o.y = pk2(bflo(w.y) * c, bfhi(w.y) * c); o.z = pk2(bflo(w.z) * c, bfhi(w.z) * c); o.w = pk2(bflo(w.w) * c, bfhi(w.w) * c);
        W.qf[ds] = __builtin_bit_cast(bf16x8, o);
    }
}

__device__ __forceinline__ float nsa_slope(int head) { return exp2f(-(float)(head + 1)); }
__device__ __forceinline__ void gqa_decode(int u, int& b, int& g, int& qb) {
    const int low6 = u & 63, hi4 = u >> 6, k = hi4 >> 2; b = hi4 >> 1; g = hi4 & 1;
    const int base = (low6 + 32 * (k >> 1)) & 63; qb = (k & 1) ? 63 - base : base;
}

__device__ __forceinline__ void unit_dilated(const Args& a, int id, LAS unsigned char* lds, int tid, int wid, int lane) {
    const int grp = id >> 9, rem = id & 511, b = rem >> 6, hp = (rem >> 5) & 1, sub = rem & 31;
    const int dil = grp == 0 ? 1 : (grp == 1 ? 4 : 16);
    const int r = sub % dil, ublk = sub / dil;
    const int hsel = wid >> 2, hi = 2 * hp + hsel;
    const bf16_t* slab0 = (const bf16_t*)(a.ws + WS_BIG) + DILS_OFF + ((size_t)(4 * grp + 2 * hp) * T + (size_t)b * SEQ + (size_t)r * (SEQ / dil)) * 64;
    const int i0w = 128 * ublk + 32 * (wid & 3);
    const float slope = exp2f(-8.0f * (float)(4 * grp + hi + 1) / 12.0f);
    AttnWave W; attn_init(W, lane, i0w, slope * LOG2E, dil);
    load_q(W, slab0 + (size_t)hsel * T * 64 + (size_t)i0w * 64, 64, lane);
    W.jlo = i0w - 128; W.jhi = i0w + 31; W.max_back = 128;
    const int slo = ublk > 0 ? 2 * ublk - 2 : 0, shi = 2 * ublk + 1; W.j0 = 64 * shi;
    AttnUnitDesc U; U.K = slab0 + (size_t)12 * T * 64; U.V = slab0 + (size_t)24 * T * 64; U.kvstride = 64; U.jclamp = SEQ / dil - 1;
    U.stmask = ((shi == 63) ? ~0ull : ((2ull << shi) - 1ull)) & ~((1ull << slo) - 1ull);
    attn_run<AT_BAND, MD_ONLINE, 2>(W, U, lds, tid, lane, nullptr, 0ull, hsel, (size_t)T * 64);
    const float lt = W.l + __shfl_xor(W.l, 32); const float inv = 1.0f / fmaxf(lt, 1e-30f);
    const size_t tok = (size_t)b * SEQ + (size_t)dil * W.iq + r;
    bf16_t* orow = (bf16_t*)(a.ws + WS_Y) + ((size_t)grp * T + tok) * 256 + hi * 64;
    const int h = lane >> 5;
#pragma unroll
    for (int blk = 0; blk < 2; ++blk)
#pragma unroll
        for (int i = 0; i < 4; ++i) { u32x2 w; w.x = pk2(W.o[blk][4 * i] * inv, W.o[blk][4 * i + 1] * inv); w.y = pk2(W.o[blk][4 * i + 2] * inv, W.o[blk][4 * i + 3] * inv);
            *(u32x2*)(orow + 32 * blk + 8 * i + 4 * h) = w; }
    if (h == 0) ((float*)(a.ws + WS_LSE))[((size_t)grp * T + tok) * 4 + hi] = (W.m + __log2f(lt) - W.sb * (float)(W.iq - W.j0)) * 0.6931471805599453f;
}

__device__ __forceinline__ void unit_nsa(const Args& a, int b, int g, int qb, LAS unsigned char* lds, int tid, int wid, int lane) {
    const bf16_t* big = (const bf16_t*)(a.ws + WS_BIG);
    const bf16_t* kvn = big + KVN_OFF + (size_t)b * SEQ * 64;
    const int hl = wid >> 1, head = g * 4 + hl, i0w = 64 * qb + 32 * (wid & 1);
    const float sl2 = nsa_slope(head) * LOG2E;
    LAS float* IMP = (LAS float*)(lds + ATT_IMP);
    for (int i = tid; i < 4 * 64 * 65; i += 512) IMP[i] = 0.f;
    const size_t tok = (size_t)b * SEQ + i0w + (lane & 31);
    const bf16_t* gp = big + tok * QGP + 512 + head * 3;
    const float g0 = sigmoidf_(bflo((unsigned)gp[0])), g1 = sigmoidf_(bflo((unsigned)gp[1])), g2 = sigmoidf_(bflo((unsigned)gp[2]));
    AttnWave W; AttnUnitDesc U;
    LAS u32x2* accl = (LAS u32x2*)(lds + ATT_ACC + wid * 4096) + lane;
    attn_init(W, lane, i0w, sl2, 1);
    load_q(W, big + ((size_t)b * SEQ + i0w) * QGP + head * 64, QGP, lane);
    {
        W.jlo = i0w - 511; W.jhi = i0w + 31; W.max_back = 511;
        const int slo = qb >= 8 ? qb - 8 : 0; W.j0 = 64 * qb;
        U.K = kvn + (size_t)(8 + g) * T * 64; U.V = kvn + (size_t)(10 + g) * T * 64; U.kvstride = 64; U.jclamp = SEQ - 1;
        U.stmask = ((qb == 63) ? ~0ull : ((2ull << qb) - 1ull)) & ~((1ull << slo) - 1ull);
        attn_run<AT_BAND, MD_ONLINE>(W, U, lds, tid, lane, nullptr, 0ull);
        const float lt = W.l + __shfl_xor(W.l, 32); const float sc = g2 / fmaxf(lt, 1e-30f);
#pragma unroll
        for (int blk = 0; blk < 2; ++blk)
#pragma unroll
            for (int i = 0; i < 4; ++i) { u32x2 w; w.x = pk2(W.o[blk][4 * i] * sc, W.o[blk][4 * i + 1] * sc); w.y = pk2(W.o[blk][4 * i + 2] * sc, W.o[blk][4 * i + 3] * sc); accl[(blk * 4 + i) * 64] = w; }
    }
    attn_init(W, lane, i0w, sl2, 16);
    {
        W.jlo = 0; W.jhi = i0w >> 4;
        const int cmax = 4 * qb + 2, shi = cmax >> 6; W.j0 = 64 * shi;
        U.K = (const bf16_t*)(a.ws + WS_KC) + (size_t)(b * 2 + g) * 256 * 64; U.V = (const bf16_t*)(a.ws + WS_VC) + (size_t)(b * 2 + g) * 256 * 64; U.kvstride = 64; U.jclamp = NCMP - 1;
        U.stmask = (2ull << shi) - 1ull;
        LAS float* impw = IMP + ((size_t)hl * 64 + 32 * (wid & 1) + (lane & 31)) * 65;
        attn_run<AT_CMP, MD_STATS>(W, U, lds, tid, lane, impw, 0ull);
        const float lt = W.l + __shfl_xor(W.l, 32);
        W.mfin = W.m; W.invl = 1.0f / fmaxf(lt, 1e-30f);
        attn_run<AT_CMP, MD_NORM>(W, U, lds, tid, lane, impw, 0ull);
#pragma unroll
        for (int blk = 0; blk < 2; ++blk)
#pragma unroll
            for (int i = 0; i < 4; ++i) { const u32x2 p = accl[(blk * 4 + i) * 64]; u32x2 w;
                w.x = pk2(bflo(p.x) + W.o[blk][4 * i] * g0, bfhi(p.x) + W.o[blk][4 * i + 1] * g0); w.y = pk2(bflo(p.y) + W.o[blk][4 * i + 2] * g0, bfhi(p.y) + W.o[blk][4 * i + 3] * g0); accl[(blk * 4 + i) * 64] = w; }
    }
    LAS unsigned long long* SELL = (LAS unsigned long long*)(lds + ATT_SELL);
    for (int qq = 8 * wid; qq < 8 * wid + 8; ++qq) {
        float val = ((IMP[(0 * 64 + qq) * 65 + lane] + IMP[(1 * 64 + qq) * 65 + lane]) + IMP[(2 * 64 + qq) * 65 + lane]) + IMP[(3 * 64 + qq) * 65 + lane];
        const int own = qb, j = lane;
        const bool forced = (j == 0) || (j == own) || (j == own - 1);
        const bool valid = j <= own;
        val = forced ? INFINITY : (valid ? val : -INFINITY);
        const unsigned key = (val == -INFINITY) ? 0u : (__builtin_bit_cast(unsigned, val) + 1u);
        unsigned Tk = 0u;
#pragma unroll
        for (int bit = 30; bit >= 0; --bit) { const unsigned c = Tk | (1u << bit); if (__builtin_popcountll(__ballot(key >= c)) >= 16) Tk = c; }
        unsigned long long msk = __ballot(key > Tk), eq = __ballot(key == Tk);
        for (int need = 16 - __builtin_popcountll(msk); need > 0; --need) { const unsigned long long low = eq & (0ull - eq); msk |= low; eq ^= low; }
        if (lane == 0) SELL[qq] = msk;
    }
    __syncthreads();
    attn_init(W, lane, i0w, sl2, 1);
    {
        W.jlo = 0; W.jhi = i0w + 31; W.j0 = 64 * qb;
        W.mysel = SELL[32 * (wid & 1) + (lane & 31)];
        unsigned lo = (unsigned)W.mysel, hi = (unsigned)(W.mysel >> 32);
#pragma unroll
        for (int o = 1; o < 64; o <<= 1) { lo |= __shfl_xor(lo, o); hi |= __shfl_xor(hi, o); }
        const unsigned long long wm = ((unsigned long long)hi << 32) | lo;
        unsigned long long um = 0ull;
#pragma unroll
        for (int q = 0; q < 64; ++q) um |= SELL[q];
        const unsigned long long causal = (qb == 63) ? ~0ull : ((2ull << qb) - 1ull);
        um &= causal; um |= 1ull;
        U.K = kvn + (size_t)(4 + g) * T * 64; U.V = kvn + (size_t)(6 + g) * T * 64; U.kvstride = 64; U.jclamp = SEQ - 1; U.stmask = um;
        attn_run<AT_SEL, MD_ONLINE>(W, U, lds, tid, lane, nullptr, wm);
        const float lt = W.l + __shfl_xor(W.l, 32); const float sc = g1 / fmaxf(lt, 1e-30f);
        bf16_t* orow = (bf16_t*)(a.ws + WS_ONSA) + tok * 512 + head * 64;
        const int h = lane >> 5;
#pragma unroll
        for (int blk = 0; blk < 2; ++blk)
#pragma unroll
            for (int i = 0; i < 4; ++i) { const u32x2 p = accl[(blk * 4 + i) * 64]; u32x2 w;
                w.x = pk2(bflo(p.x) + W.o[blk][4 * i] * sc, bfhi(p.x) + W.o[blk][4 * i + 1] * sc); w.y = pk2(bflo(p.y) + W.o[blk][4 * i + 2] * sc, bfhi(p.y) + W.o[blk][4 * i + 3] * sc);
                *(u32x2*)(orow + 32 * blk + 8 * i + 4 * h) = w; }
    }
}

constexpr int LDS_BIAS = 131072;
__device__ __forceinline__ void unit_compress_full(const Args& a, int id, LAS unsigned char* lds, int tid_in) {
    const int which = id >> 4, b = (id >> 1) & 7, g = id & 1;
    LAS float* bias = (LAS float*)(lds + LDS_BIAS);
    int tid = tid_in; asm volatile("" : "+v"(tid));
    if (tid < 256) bias[tid] = ((const float*)(a.ws + WS_BIASP + 0x10000))[which * 256 + tid];
    __syncthreads();
    bf16_t* CH = (bf16_t*)(a.ws + WS_CH) + (size_t)id * 65536;
    {
        int K = 2048; asm volatile("" : "+s"(K));
        pg8::Gemm gm{(const bf16_t*)(a.ws + WS_BIG), (const bf16_t*)(a.ws + (which ? WS_WCV1 : WS_WCK1)), K, 16 * 64, 128, 2048};
        int one = 1; asm volatile("" : "+s"(one));
        pg8::OneUnit S{(KVN_OFF + ((size_t)(which * 2 + g) * T + (size_t)b * SEQ) * 64) * 2, one};
        pg8::Epi<pg8::EP_STORE> E{CH, 256, nullptr, nullptr, nullptr};
        pg8::gemm_phase<pg8::Epi<pg8::EP_STORE>, pg8::OneUnit, true>(lds, gm, S, E);
    }
    __threadfence();
    __syncthreads();
    tid = tid_in; asm volatile("" : "+v"(tid));
    {
        const int lane = tid & 63, wv = tid >> 6, fr = lane & 15, fq = lane >> 4;
        const bf16_t* w2t = (const bf16_t*)(a.ws + WS_SELM + (which ? 0x8000 : 0));
        f32x4 acc[2][4];
#pragma unroll
        for (int rt = 0; rt < 2; ++rt)
#pragma unroll
            for (int ct = 0; ct < 4; ++ct) acc[rt][ct] = (f32x4){0.f, 0.f, 0.f, 0.f};
        for (int ks = 0; ks < 8; ++ks) {
            const int k0 = 32 * ks + 8 * fq;
            const f32x4 b0 = *(const LAS f32x4*)(bias + k0), b1 = *(const LAS f32x4*)(bias + k0 + 4);
            bf16x8 af[2], bfr[4];
#pragma unroll
            for (int rt = 0; rt < 2; ++rt) {
                const u32x4 hv = *(const u32x4*)(CH + (size_t)(32 * wv + 16 * rt + fr) * 256 + k0);
                float hx[8] = {bflo(hv.x) + b0.x, bfhi(hv.x) + b0.y, bflo(hv.y) + b0.z, bfhi(hv.y) + b0.w, bflo(hv.z) + b1.x, bfhi(hv.z) + b1.y, bflo(hv.w) + b1.z, bfhi(hv.w) + b1.w};
#pragma unroll
                for (int e = 0; e < 8; ++e) { const float x = hx[e]; const float z = 0.7978845608028654f * (x + 0.044715f * x * x * x); hx[e] = x * sigmoidf_(2.0f * z); }
                u32x4 w; w.x = pk2(hx[0], hx[1]); w.y = pk2(hx[2], hx[3]); w.z = pk2(hx[4], hx[5]); w.w = pk2(hx[6], hx[7]);
                af[rt] = __builtin_bit_cast(bf16x8, w);
            }
#pragma unroll
            for (int ct = 0; ct < 4; ++ct) bfr[ct] = *(const bf16x8*)(w2t + (size_t)(16 * ct + fr) * 256 + k0);
#pragma unroll
            for (int rt = 0; rt < 2; ++rt)
#pragma unroll
                for (int ct = 0; ct < 4; ++ct) acc[rt][ct] = __builtin_amdgcn_mfma_f32_16x16x32_bf16(bfr[ct], af[rt], acc[rt][ct], 0, 0, 0);
        }
        bf16_t* obase = (bf16_t*)(a.ws + (which ? WS_VC : WS_KC)) + (size_t)(b * 2 + g) * 256 * 64;
#pragma unroll
        for (int rt = 0; rt < 2; ++rt) { const int c = 32 * wv + 16 * rt + fr;
            if (c < NCMP) {
#pragma unroll
                for (int ct = 0; ct < 4; ++ct) { u32x2 w; w.x = pk2(acc[rt][ct][0], acc[rt][ct][1]); w.y = pk2(acc[rt][ct][2], acc[rt][ct][3]); *(u32x2*)(obase + (size_t)c * 64 + 16 * ct + 4 * fq) = w; }
            } }
    }
    __syncthreads();
}

__device__ __forceinline__ void dil_combine(const Args& a, int gtid, int ngt) {
    const bf16_t* odg = (const bf16_t*)(a.ws + WS_Y); const float* lse = (const float*)(a.ws + WS_LSE); bf16_t* od = (bf16_t*)(a.ws + WS_ODIL);
    for (size_t it = gtid; it < (size_t)T * 32; it += ngt) {
        const size_t tok = it >> 5; const int c8 = (int)(it & 31), hi = c8 >> 3;
        const float l0 = lse[tok * 4 + hi], l1 = lse[((size_t)T + tok) * 4 + hi], l2 = lse[((size_t)2 * T + tok) * 4 + hi];
        const float mx = fmaxf(l0, fmaxf(l1, l2));
        float w0 = __expf(l0 - mx), w1 = __expf(l1 - mx), w2 = __expf(l2 - mx); const float inv = 1.0f / (w0 + w1 + w2); w0 *= inv; w1 *= inv; w2 *= inv;
        const u32x4 p0 = *(const u32x4*)(odg + tok * 256 + c8 * 8), p1 = *(const u32x4*)(odg + ((size_t)T + tok) * 256 + c8 * 8), p2 = *(const u32x4*)(odg + ((size_t)2 * T + tok) * 256 + c8 * 8);
        u32x4 o;
        o.x = pk2(w0 * bflo(p0.x) + w1 * bflo(p1.x) + w2 * bflo(p2.x), w0 * bfhi(p0.x) + w1 * bfhi(p1.x) + w2 * bfhi(p2.x));
        o.y = pk2(w0 * bflo(p0.y) + w1 * bflo(p1.y) + w2 * bflo(p2.y), w0 * bfhi(p0.y) + w1 * bfhi(p1.y) + w2 * bfhi(p2.y));
        o.z = pk2(w0 * bflo(p0.z) + w1 * bflo(p1.z) + w2 * bflo(p2.z), w0 * bfhi(p0.z) + w1 * bfhi(p1.z) + w2 * bfhi(p2.z));
        o.w = pk2(w0 * bflo(p0.w) + w1 * bflo(p1.w) + w2 * bflo(p2.w), w0 * bfhi(p0.w) + w1 * bfhi(p1.w) + w2 * bfhi(p2.w));
        *(u32x4*)(od + tok * 256 + c8 * 8) = o;
    }
}


#define XB_TMO      128
#define XB_XCNT(j)  (256  + 64 * (j))
#define XB_XSUB(j)  (1280 + 64 * (j))
#define XB_XGEN(j)  (2304 + 64 * (j))
#define XB_TOP      3328
#define XB_TOPGEN   3392
#define XCD_BAR_WORDS 3456
#define XB_SPIN_CAP (1u << 18)
__device__ __forceinline__ unsigned xb_ld(unsigned* p)              { return __hip_atomic_load(p, __ATOMIC_RELAXED, __HIP_MEMORY_SCOPE_AGENT); }
__device__ __forceinline__ unsigned xb_add(unsigned* p, unsigned v) { return __hip_atomic_fetch_add(p, v, __ATOMIC_RELAXED, __HIP_MEMORY_SCOPE_AGENT); }
__device__ __forceinline__ unsigned xb_xcc_id() { return (unsigned)__builtin_amdgcn_s_getreg((3 << 11) | 20) & 0xFu; }
#define XB_SPIN(cond, bar) do { unsigned _sp = 0; while (cond) { __builtin_amdgcn_s_sleep(1); \
    if ((++_sp & 255u) == 0u) { if (xb_ld(&(bar)[XB_TMO])) break; if (_sp > XB_SPIN_CAP) { atomicAdd(&(bar)[XB_TMO], 1u); break; } } } } while (0)
struct XcdBarrier { unsigned* bar; unsigned x; volatile LAS unsigned* st; };
__device__ __forceinline__ XcdBarrier xcd_barrier_post(unsigned* bar, volatile LAS unsigned* st) {
    XcdBarrier b; b.bar = bar; b.x = xb_xcc_id(); b.st = st;
    if (threadIdx.x == 0) (void)xb_add(&bar[XB_XCNT(b.x)], 1u);
    return b;
}
__device__ __forceinline__ void xcd_barrier_complete(unsigned* bar, unsigned x, unsigned& nloc, unsigned& nx) {
    const unsigned G = gridDim.x * gridDim.y * gridDim.z;
    unsigned sum, cnt, mine, sp = 0u;
    for (;;) {
        sum = 0u; cnt = 0u; mine = 0u;
#pragma unroll
        for (unsigned j = 0; j < 16; ++j) { const unsigned c = xb_ld(&bar[XB_XCNT(j)]); sum += c; cnt += (c > 0u) ? 1u : 0u; mine = (j == x) ? c : mine; }
        if (sum == G) break;
        __builtin_amdgcn_s_sleep(1);
        if ((++sp & 255u) == 0u) { if (xb_ld(&bar[XB_TMO])) break; if (sp > XB_SPIN_CAP) { atomicAdd(&bar[XB_TMO], 1u); break; } }
    }
    nloc = mine > 0u ? mine : 1u; nx = cnt > 0u ? cnt : 1u;
}
__device__ __forceinline__ void xcd_barrier(const XcdBarrier& b) {
    asm volatile("s_waitcnt vmcnt(0)" ::: "memory");
    __syncthreads();
    if (threadIdx.x == 0) {
        unsigned* bar = b.bar;
        __builtin_amdgcn_s_waitcnt(0);
        unsigned nloc = b.st[0], nx = b.st[1];
        if (nloc == 0u) { xcd_barrier_complete(bar, b.x, nloc, nx); b.st[0] = nloc; b.st[1] = nx; }
        const unsigned old = xb_add(&bar[XB_XSUB(b.x)], 1u);
        const unsigned gen = old / nloc;
        if (old + 1u == (gen + 1u) * nloc) {
            __builtin_amdgcn_fence(__ATOMIC_RELEASE, "agent");
            asm volatile("s_waitcnt vmcnt(0)" ::: "memory");
            const unsigned og = xb_add(&bar[XB_TOP], 1u);
            const unsigned tg = og / nx;
            if (og + 1u == (tg + 1u) * nx) xb_add(&bar[XB_TOPGEN], 1u);
            else XB_SPIN(xb_ld(&bar[XB_TOPGEN]) == tg, bar);
            __builtin_amdgcn_fence(__ATOMIC_ACQUIRE, "agent");
            xb_add(&bar[XB_XGEN(b.x)], 1u);
            asm volatile("s_waitcnt vmcnt(0)" ::: "memory");
        } else {
            XB_SPIN(xb_ld(&bar[XB_XGEN(b.x)]) == gen, bar);
            __builtin_amdgcn_fence(__ATOMIC_ACQUIRE, "agent");
            asm volatile("s_waitcnt vmcnt(0)" ::: "memory");
        }
    }
    __syncthreads();
}

constexpr int NPHASE = 13;
constexpr int LDS_BYTES = 147456;
template <int MODE>
__device__ __forceinline__ void run_gemm(LAS unsigned char* lds, const bf16_t* A, const bf16_t* Bt, int N, int K, bf16_t* O, int ldc, const bf16_t* P1, const bf16_t* P2) {
    asm volatile("" : "+s"(K));
    pg8::Gemm g{A, Bt, K, K, pg8::BK * 2, K};
    pg8::StaticOrder S; S.init(T, N, (int)gridDim.x, (int)blockIdx.x, K);
    pg8::Epi<MODE> E{O, ldc, P1, P2, nullptr};
    pg8::gemm_phase<pg8::Epi<MODE>, pg8::StaticOrder, true>(lds, g, S, E);
}

__global__ void __launch_bounds__(512, 2) mk_fwd(Args a) {
    extern __shared__ __attribute__((aligned(16))) unsigned char lds_raw[];
    LAS unsigned char* lds = (LAS unsigned char*)lds_raw;
    const int G = gridDim.x, bid = blockIdx.x;
#define IDS() int tid = threadIdx.x; asm volatile("" : "+v"(tid)); const int lane = tid & 63, wid = __builtin_amdgcn_readfirstlane(tid >> 6); const int gw = bid * 8 + wid, ngw = G * 8; (void)gw; (void)ngw; (void)lane

    unsigned char* ws = a.ws;
    bf16_t* H = (bf16_t*)(ws + WS_H); bf16_t* Y = (bf16_t*)(ws + WS_Y); bf16_t* BIG = (bf16_t*)(ws + WS_BIG);
    cg::grid_group grid = cg::this_grid();
    if (a.ph_lo < 0) grid.sync();
    volatile LAS unsigned* MISCW = (volatile LAS unsigned*)(lds + LDS_BYTES - 64);
    if (threadIdx.x < 4) MISCW[threadIdx.x] = 0u;
    __syncthreads();
    XcdBarrier bar; bar.bar = (unsigned*)ws; bar.x = 0; bar.st = MISCW;
    if (a.ph_hi - a.ph_lo > 1) bar = xcd_barrier_post((unsigned*)ws, MISCW);
#ifndef PHASE_MASK
#define PHASE_MASK 0xFFFFF
#endif
#define IN(k) ((((PHASE_MASK) >> (k)) & 1) && a.ph_lo <= (k) && (k) < a.ph_hi)
#ifndef REPEAT_MASK
#define REPEAT_MASK 0
#endif
#define REP(k) for (int rep_ = 0; rep_ < ((((REPEAT_MASK) >> (k)) & 1) ? 2 : 1); ++rep_)
#define SEAM(k) do { if (IN(k) && IN((k) + 1)) xcd_barrier(bar); } while (0)

    if (IN(0)) REP(0) {
        IDS();
        int base = 0;
        for (int m = 0; m < W_NMAT; ++m) {
            const MatDesc md = mat_desc(m); const int nit = (md.K / 64) * (md.Nd / 64);
            int first = (gw - base % ngw + ngw) % ngw;
            for (int it = first; it < nit; it += ngw) transpose_item(a, m, it, lane);
            base += nit;
        }
        for (int t = gw; t < 64; t += ngw) {
            const int which = t >> 5, ch = t & 31; const float* pe = a.in[which ? 12 : 9]; const float* w1 = a.in[which ? 13 : 10];
            float s[4] = {0.f, 0.f, 0.f, 0.f};
            for (int k = 64 * ch; k < 64 * ch + 64; ++k) { const float p = pe[k];
#pragma unroll
                for (int j = 0; j < 4; ++j) s[j] += p * w1[(size_t)k * 256 + lane + 64 * j]; }
#pragma unroll
            for (int j = 0; j < 4; ++j) ((float*)(ws + WS_BIASP))[(size_t)t * 256 + lane + 64 * j] = s[j];
        }
        row_pass<false, false>(a.in[0], nullptr, 0.f, nullptr, nullptr, a.in[1], H, gw, ngw, lane);
    }
    SEAM(0);
#ifndef EXTRA_SYNC
#define EXTRA_SYNC 0
#endif
    for (int es_ = 0; es_ < EXTRA_SYNC; ++es_) xcd_barrier(bar);
    if (IN(1)) REP(1) run_gemm<pg8::EP_SWIGLU>(lds, H, (const bf16_t*)(ws + WS_WGU1), NGU, D, BIG, FF, nullptr, nullptr);
    SEAM(1);
    if (IN(2)) REP(2) run_gemm<pg8::EP_STORE>(lds, BIG, (const bf16_t*)(ws + WS_WD1), D, FF, Y, D, nullptr, nullptr);
    SEAM(2);
    if (IN(3)) REP(3) { IDS(); row_pass<false, true>(a.in[0], Y, 0.5f, a.in[2], a.out, a.in[6], H, gw, ngw, lane);
        if (bid == 0) { const float* bp = (const float*)(ws + WS_BIASP) + (size_t)(tid >> 8) * 32 * 256 + (tid & 255); float sbias = 0.f;
            for (int c = 0; c < 32; ++c) sbias += bp[c * 256];
            ((float*)(ws + WS_BIASP + 0x10000))[tid] = sbias; } }
    SEAM(3);
    if (IN(4)) REP(4) run_gemm<pg8::EP_PROJ>(lds, H, (const bf16_t*)(ws + WS_WIN), PITCH, D, BIG, PITCH, nullptr, nullptr);
    SEAM(4);
    if (IN(5)) REP(5) {
        { int tid0 = threadIdx.x; asm volatile("" : "+v"(tid0)); for (int u = bid; u < 32; u += G) unit_compress_full(a, u, lds, tid0); }
        IDS();
        int first, nmine, stride = 1;
        if (G == 256) {
            if (bid < 32) { first = 0; nmine = 0; }
            else { const int w = bid - 32; if (w < 192) { first = 7 * w; nmine = 7; } else { first = 1344 + 6 * (w - 192); nmine = 6; } }
        } else { first = bid; stride = G; nmine = bid < 1536 ? (1536 - bid + G - 1) / G : 0; }
        for (int k = 0; k < nmine; ++k) unit_dilated(a, first + k * stride, lds, tid, wid, lane);
    }
    SEAM(5);
    if (IN(6)) REP(6) {
        IDS();
        if (G == 256) {
            const int x = bid & 7, j = bid >> 3;
            for (int k = 0; k < 4; ++k) { const int p = x + 8 * (k >> 1); unit_nsa(a, p >> 1, p & 1, (k & 1) ? 63 - j : j, lds, tid, wid, lane); }
        } else { for (int u = bid; u < 1024; u += G) { int b, g, qb; gqa_decode(u, b, g, qb); unit_nsa(a, b, g, qb, lds, tid, wid, lane); } }
        dil_combine(a, bid * 512 + tid, G * 512);
    }
    SEAM(6);
    if (IN(7)) REP(7) {
        run_gemm<pg8::EP_SIG>(lds, H, (const bf16_t*)(ws + WS_WGA), D, D, Y, D, nullptr, nullptr);
        run_gemm<pg8::EP_MUL>(lds, (const bf16_t*)(ws + WS_ONSA), (const bf16_t*)(ws + WS_WN), D, 512, Y, D, Y, nullptr);
        run_gemm<pg8::EP_SIG>(lds, H, (const bf16_t*)(ws + WS_WGB), D, D, BIG, D, nullptr, nullptr);
        run_gemm<pg8::EP_FINAL>(lds, (const bf16_t*)(ws + WS_ODIL), (const bf16_t*)(ws + WS_WDIL), D, 256, Y, D, Y, BIG);
    }
    SEAM(7);
    if (IN(8)) REP(8) run_gemm<pg8::EP_STORE>(lds, Y, (const bf16_t*)(ws + WS_WMIX), D, D, BIG + (size_t)32 * MiB, D, nullptr, nullptr);
    SEAM(8);
    if (IN(9)) REP(9) { IDS(); row_pass<true, true>(a.out, BIG + (size_t)32 * MiB, 1.0f, a.in[7], ws + WS_ONSA, a.in[18], H, gw, ngw, lane); }
    SEAM(9);
    if (IN(10)) REP(10) run_gemm<pg8::EP_SWIGLU>(lds, H, (const bf16_t*)(ws + WS_WGU2), NGU, D, BIG, FF, nullptr, nullptr);
    SEAM(10);
    if (IN(11)) REP(11) run_gemm<pg8::EP_STORE>(lds, BIG, (const bf16_t*)(ws + WS_WD2), D, FF, Y, D, nullptr, nullptr);
    SEAM(11);
    if (IN(12)) REP(12) { IDS(); row_pass<true, false>(ws + WS_ONSA, Y, 0.5f, a.in[19], a.out, nullptr, nullptr, gw, ngw, lane); }
#undef IN
#undef SEAM
}

#ifndef MK_ONE_LAUNCH
#define MK_ONE_LAUNCH 1
#endif
extern "C" void kernel_launch(void* const* d_in, const int* in_sizes, int n_in, void* d_out, int out_size, void* d_ws, size_t ws_size, hipStream_t stream) {
    static int grid = 0;
    if (grid == 0) {
        if (n_in != 23 || ws_size < WS_END) { fprintf(stderr, "kernel_launch: unexpected n_in %d / ws_size %zu\n", n_in, ws_size); grid = -1; return; }
        int dev = 0, cus = 0, per_cu = 0;
        hipGetDevice(&dev); hipDeviceGetAttribute(&cus, hipDeviceAttributeMultiprocessorCount, dev);
        hipFuncSetAttribute((const void*)mk_fwd, hipFuncAttributeMaxDynamicSharedMemorySize, LDS_BYTES);
        hipOccupancyMaxActiveBlocksPerMultiprocessor(&per_cu, (const void*)mk_fwd, 512, LDS_BYTES);
        if (per_cu < 1) { fprintf(stderr, "kernel_launch: occupancy query returned %d\n", per_cu); per_cu = 1; }
        (void)hipGetLastError();
        grid = cus * 1;
    }
    if (grid < 0) return;
    if (hipMemsetAsync(d_ws, 0, 16384, stream) != hipSuccess) fprintf(stderr, "kernel_launch: memset failed\n");
    Args a{};
    for (int i = 0; i < 23; ++i) a.in[i] = (const float*)d_in[i];
    a.out = (float*)d_out; a.ws = (unsigned char*)d_ws;
#if MK_ONE_LAUNCH
    a.ph_lo = 0; a.ph_hi = NPHASE;
    void* args[] = {&a};
    hipError_t e = hipLaunchCooperativeKernel((const void*)mk_fwd, dim3(grid), dim3(512), args, LDS_BYTES, stream);
    if (e != hipSuccess) fprintf(stderr, "cooperative launch failed: %s (grid %d)\n", hipGetErrorString(e), grid);
#else
    for (int p = 0; p < NPHASE; ++p) { a.ph_lo = p; a.ph_hi = p + 1; hipLaunchKernelGGL(mk_fwd, dim3(grid), dim3(512), LDS_BYTES, stream, a); }
#endif
}
```
